# Optimizing an MI355X kernel written in HIP

```python
import math
import jax, jax.numpy as jnp
from jax import lax
import numpy as np

D_MODEL = 1024
BATCH = 4
SEQ = 8192
DEPTH = 4

N_MIXERS = 3
N_HEADS = 16
HEAD_DIM = 64
BLOCK = 128
SWA_KV_HEADS = 2
SWA_WINDOW = 128
DIL_PATTERNS = ((128, 1), (512, 4), (2048, 16))
MLA_Q_RANK = 256
MLA_KV_RANK = 128
MLA_NOPE = 64
MLA_ROPE = 32
MLA_V = 64
ROPE_THETA = 10000.0
REL_BUCKETS = 32
REL_MAX_DIST = 2048
PEER_HEADS = 8
PEER_KEYS = 128
PEER_EXPERTS = PEER_KEYS * PEER_KEYS
PEER_DKEY = 256
PEER_TOPK = 16
PEER_CHUNK = 128
DN_ALPHA = (2 * DEPTH) ** 0.25
DN_BETA = (8 * DEPTH) ** -0.25
LN_EPS = 1e-5
RMS_EPS = 1e-6
NEG = -1e30

N_SWA = (DEPTH + 2) // 3
N_DIL = (DEPTH + 1) // 3
N_MLA = DEPTH // 3

kernel_name = "hybrid_swa_dilated_mla_peer_deepnorm"

f32 = jnp.float32


def layer_norm(x, g, b):
    xf = x.astype(f32)
    mu = xf.mean(-1, keepdims=True)
    var = jnp.square(xf - mu).mean(-1, keepdims=True)
    return ((xf - mu) * lax.rsqrt(var + LN_EPS) * g + b).astype(x.dtype)


def rms_norm(x, g):
    xf = x.astype(f32)
    return (xf * lax.rsqrt(jnp.square(xf).mean(-1, keepdims=True) + RMS_EPS) * g).astype(x.dtype)


def rel_bucket(dist):
    max_exact = REL_BUCKETS // 2
    n = jnp.maximum(dist, 0)
    nf = jnp.maximum(n, 1).astype(f32)
    large = max_exact + (jnp.log(nf / max_exact) / math.log(REL_MAX_DIST / max_exact)
                         * (REL_BUCKETS - max_exact)).astype(jnp.int32)
    large = jnp.minimum(large, REL_BUCKETS - 1)
    return jnp.where(n < max_exact, n, large)


def banded_attention(q, k, v, rel_bias, max_dist, dilation):
    b, hk, g, L, dh = q.shape
    nb = L // BLOCK
    qb = q.reshape(b, hk, g, nb, BLOCK, dh)

    def band(t):
        tb = t.reshape(b, hk, nb, BLOCK, t.shape[-1])
        prev = jnp.concatenate([jnp.zeros_like(tb[:, :, :1]), tb[:, :, :-1]], axis=2)
        return jnp.concatenate([prev, tb], axis=3)

    kb, vb = band(k), band(v)
    s = jnp.einsum('bhgnqd,bhnkd->bhgnqk', qb, kb).astype(f32) * (dh ** -0.5)
    qi = jnp.arange(BLOCK)[:, None]
    kj = jnp.arange(2 * BLOCK)[None, :]
    dist = BLOCK + qi - kj
    bias = rel_bias[rel_bucket(dist * dilation)].astype(f32)
    bias = jnp.moveaxis(bias, -1, 0).reshape(hk, g, BLOCK, 2 * BLOCK)
    valid = ((dist >= 0) & (dist <= max_dist))[None] & \
        ((jnp.arange(nb)[:, None, None] > 0) | (kj >= BLOCK)[None])
    s = jnp.where(valid, s + bias[:, :, None], NEG)
    m = s.max(-1, keepdims=True)
    p = jnp.exp(s - m)
    l = p.sum(-1, keepdims=True)
    o = jnp.einsum('bhgnqk,bhnkd->bhgnqd', p, vb) / l
    lse = (m + jnp.log(l))[..., 0]
    return o.reshape(b, hk, g, L, dh), lse.reshape(b, hk, g, L)


def swa_mixer(x, w_in, sinks, w_out, rel_bias):
    b, s, _ = x.shape
    grp = N_HEADS // SWA_KV_HEADS
    q, k, v = jnp.split(x @ w_in, [N_HEADS * HEAD_DIM, (N_HEADS + SWA_KV_HEADS) * HEAD_DIM], axis=-1)
    q = q.reshape(b, s, SWA_KV_HEADS, grp, HEAD_DIM).transpose(0, 2, 3, 1, 4)
    k = k.reshape(b, s, SWA_KV_HEADS, HEAD_DIM).transpose(0, 2, 1, 3)
    v = v.reshape(b, s, SWA_KV_HEADS, HEAD_DIM).transpose(0, 2, 1, 3)
    o, lse = banded_attention(q, k, v, rel_bias, SWA_WINDOW - 1, 1)
    sink = sinks.astype(f32).reshape(SWA_KV_HEADS, grp)[None, :, :, None]
    o = o * jax.nn.sigmoid(lse - sink)[..., None]
    o = o.transpose(0, 3, 1, 2, 4).reshape(b, s, N_HEADS * HEAD_DIM).astype(x.dtype)
    return o @ w_out


def dilated_mixer(x, w_in, w_out, rel_bias):
    b, s, _ = x.shape
    n_pat = len(DIL_PATTERNS)
    proj = (x @ w_in).reshape(b, s, n_pat, 3, N_HEADS, HEAD_DIM)
    outs, lses = [], []
    for gi, (window, dil) in enumerate(DIL_PATTERNS):
        seg = dil * BLOCK
        sp = -(-s // seg) * seg
        t = jnp.pad(proj[:, :, gi], ((0, 0), (0, sp - s), (0, 0), (0, 0), (0, 0)))
        m_len = sp // dil
        t = t.reshape(b, m_len, dil, 3, N_HEADS, HEAD_DIM).transpose(3, 0, 2, 4, 1, 5)
        t = t.reshape(3, b * dil, N_HEADS, m_len, HEAD_DIM)
        o, lse = banded_attention(t[0][:, :, None], t[1], t[2], rel_bias, window // dil, dil)
        o = o[:, :, 0].reshape(b, dil, N_HEADS, m_len, HEAD_DIM).transpose(0, 3, 1, 2, 4)
        o = o.reshape(b, sp, N_HEADS, HEAD_DIM)[:, :s]
        lse = lse[:, :, 0].reshape(b, dil, N_HEADS, m_len).transpose(0, 3, 1, 2).reshape(b, sp, N_HEADS)[:, :s]
        outs.append(o)
        lses.append(lse)
    o = jnp.stack(outs, 0)
    wts = jax.nn.softmax(jnp.stack(lses, 0), axis=0)
    o = (wts[..., None] * o).sum(0).reshape(b, s, N_HEADS * HEAD_DIM).astype(x.dtype)
    return o @ w_out


def rope(t, pos):
    half = t.shape[-1] // 2
    freq = ROPE_THETA ** (-jnp.arange(half, dtype=f32) / half)
    ang = pos[:, None].astype(f32) * freq[None, :]
    cos, sin = jnp.cos(ang), jnp.sin(ang)
    tf = t.astype(f32)
    t1, t2 = tf[..., :half], tf[..., half:]
    return jnp.concatenate([t1 * cos - t2 * sin, t1 * sin + t2 * cos], -1).astype(t.dtype)


def mla_mixer(x, w_in, q_norm, w_uq, kv_norm, w_ukv, w_out):
    b, s, _ = x.shape
    c_q, c_kv, k_r = jnp.split(x @ w_in, [MLA_Q_RANK, MLA_Q_RANK + MLA_KV_RANK], axis=-1)
    q = (rms_norm(c_q, q_norm) @ w_uq).reshape(b, s, N_HEADS, MLA_NOPE + MLA_ROPE).transpose(0, 2, 1, 3)
    kv = (rms_norm(c_kv, kv_norm) @ w_ukv).reshape(b, s, N_HEADS, MLA_NOPE + MLA_V).transpose(0, 2, 1, 3)
    pos = jnp.arange(s)
    q = jnp.concatenate([q[..., :MLA_NOPE], rope(q[..., MLA_NOPE:], pos)], -1)
    k_r = rope(k_r[:, None], pos)
    k = jnp.concatenate([kv[..., :MLA_NOPE], jnp.broadcast_to(k_r, (b, N_HEADS, s, MLA_ROPE))], -1)
    v = kv[..., MLA_NOPE:]
    scale = (MLA_NOPE + MLA_ROPE) ** -0.5
    nb = s // BLOCK
    qb = q.reshape(b, N_HEADS, nb, BLOCK, MLA_NOPE + MLA_ROPE).transpose(2, 0, 1, 3, 4)

    def query_block(args):
        qblk, n = args
        sc = jnp.einsum('bhqd,bhkd->bhqk', qblk, k).astype(f32) * scale
        qpos = n * BLOCK + jnp.arange(BLOCK)
        sc = jnp.where(pos[None, :] <= qpos[:, None], sc, NEG)
        return jnp.einsum('bhqk,bhkd->bhqd', jax.nn.softmax(sc, axis=-1), v)

    o = lax.map(query_block, (qb, jnp.arange(nb)))
    o = o.transpose(1, 0, 3, 2, 4).reshape(b, s, N_HEADS * MLA_V).astype(x.dtype)
    return o @ w_out


def peer(x, w_q, keys, u, v):
    b, s, d = x.shape
    t = x.reshape(b * s, d)
    n_tok = b * s
    q = (t @ w_q).reshape(n_tok, PEER_HEADS, 2, PEER_DKEY // 2)
    sc = jnp.einsum('thpd,hpkd->thpk', q, keys).astype(f32)
    s_top, i_top = lax.top_k(sc, PEER_TOPK)
    cand = s_top[:, :, 0, :, None] + s_top[:, :, 1, None, :]
    cand_idx = i_top[:, :, 0, :, None] * PEER_KEYS + i_top[:, :, 1, None, :]
    best, sel = lax.top_k(cand.reshape(n_tok, PEER_HEADS, PEER_TOPK * PEER_TOPK), PEER_TOPK)
    idx = jnp.take_along_axis(cand_idx.reshape(n_tok, PEER_HEADS, -1), sel, axis=-1)
    gate = jax.nn.softmax(best, axis=-1)
    nc = n_tok // PEER_CHUNK
    hk = PEER_HEADS * PEER_TOPK

    def token_chunk(args):
        tc, ic, gc = args
        ue = jnp.take(u, ic, axis=0)
        ve = jnp.take(v, ic, axis=0)
        h = jax.nn.gelu(jnp.einsum('cd,ced->ce', tc, ue).astype(f32), approximate=False)
        return jnp.einsum('ce,ced->cd', gc * h, ve)

    y = lax.map(token_chunk, (t.reshape(nc, PEER_CHUNK, d), idx.reshape(nc, PEER_CHUNK, hk),
                              gate.reshape(nc, PEER_CHUNK, hk)))
    return y.reshape(b, s, d).astype(x.dtype)


def setup_inputs(seed: int = 0) -> dict:
    key = jax.random.key(seed)
    ks = iter(jax.random.split(key, 32))
    D = D_MODEL

    def nrm(shape, scale):
        return jax.random.normal(next(ks), shape, f32) * scale

    x = nrm((BATCH, SEQ, D), 1.0)
    rel_bias = nrm((REL_BUCKETS, N_HEADS), 0.5)
    ln_g = 1.0 + nrm((DEPTH, 2, D), 0.02)
    ln_b = nrm((DEPTH, 2, D), 0.02)
    swa_w_in = nrm((N_SWA, D, (N_HEADS + 2 * SWA_KV_HEADS) * HEAD_DIM), D ** -0.5)
    swa_sinks = nrm((N_SWA, N_HEADS), 1.0)
    swa_w_out = nrm((N_SWA, N_HEADS * HEAD_DIM, D), DN_BETA * (N_HEADS * HEAD_DIM) ** -0.5)
    dil_w_in = nrm((N_DIL, D, len(DIL_PATTERNS) * 3 * N_HEADS * HEAD_DIM), D ** -0.5)
    dil_w_out = nrm((N_DIL, N_HEADS * HEAD_DIM, D), DN_BETA * (N_HEADS * HEAD_DIM) ** -0.5)
    mla_w_in = nrm((N_MLA, D, MLA_Q_RANK + MLA_KV_RANK + MLA_ROPE), D ** -0.5)
    mla_q_norm = 1.0 + nrm((N_MLA, MLA_Q_RANK), 0.02)
    mla_w_uq = nrm((N_MLA, MLA_Q_RANK, N_HEADS * (MLA_NOPE + MLA_ROPE)), MLA_Q_RANK ** -0.5)
    mla_kv_norm = 1.0 + nrm((N_MLA, MLA_KV_RANK), 0.02)
    mla_w_ukv = nrm((N_MLA, MLA_KV_RANK, N_HEADS * (MLA_NOPE + MLA_V)), MLA_KV_RANK ** -0.5)
    mla_w_out = nrm((N_MLA, N_HEADS * MLA_V, D), DN_BETA * (N_HEADS * MLA_V) ** -0.5)
    peer_w_q = nrm((DEPTH, D, PEER_HEADS * PEER_DKEY), D ** -0.5)
    peer_keys = nrm((DEPTH, PEER_HEADS, 2, PEER_KEYS, PEER_DKEY // 2), (PEER_DKEY // 2) ** -0.5)
    peer_u = nrm((DEPTH, PEER_EXPERTS, D), D ** -0.5)
    peer_v = nrm((DEPTH, PEER_EXPERTS, D), DN_BETA * PEER_HEADS ** -0.5)
    return {"x": x, "rel_bias": rel_bias, "ln_g": ln_g, "ln_b": ln_b,
            "swa_w_in": swa_w_in, "swa_sinks": swa_sinks, "swa_w_out": swa_w_out,
            "dil_w_in": dil_w_in, "dil_w_out": dil_w_out,
            "mla_w_in": mla_w_in, "mla_q_norm": mla_q_norm, "mla_w_uq": mla_w_uq,
            "mla_kv_norm": mla_kv_norm, "mla_w_ukv": mla_w_ukv, "mla_w_out": mla_w_out,
            "peer_w_q": peer_w_q, "peer_keys": peer_keys, "peer_u": peer_u, "peer_v": peer_v}


def reference(x, rel_bias, ln_g, ln_b, swa_w_in, swa_sinks, swa_w_out, dil_w_in, dil_w_out,
              mla_w_in, mla_q_norm, mla_w_uq, mla_kv_norm, mla_w_ukv, mla_w_out,
              peer_w_q, peer_keys, peer_u, peer_v):
    for i in range(DEPTH):
        kind, j = i % N_MIXERS, i // N_MIXERS
        if kind == 0:
            y = swa_mixer(x, swa_w_in[j], swa_sinks[j], swa_w_out[j], rel_bias)
        elif kind == 1:
            y = dilated_mixer(x, dil_w_in[j], dil_w_out[j], rel_bias)
        else:
            y = mla_mixer(x, mla_w_in[j], mla_q_norm[j], mla_w_uq[j], mla_kv_norm[j],
                          mla_w_ukv[j], mla_w_out[j])
        x = layer_norm(DN_ALPHA * x + y, ln_g[i, 0], ln_b[i, 0])
        y = peer(x, peer_w_q[i], peer_keys[i], peer_u[i], peer_v[i])
        x = layer_norm(DN_ALPHA * x + y, ln_g[i, 1], ln_b[i, 1])
    return x
```

```cpp
#include <hip/hip_runtime.h>
#include <hip/hip_cooperative_groups.h>
#include <cstdio>
#include <cstdint>
namespace cg = cooperative_groups;

#ifndef ZERO_ATTN_MASK
#define ZERO_ATTN_MASK 0
#endif
#ifndef ZERO_PEER_MASK
#define ZERO_PEER_MASK 0
#endif
#ifndef ONE_LAUNCH
#define ONE_LAUNCH 1
#endif

typedef unsigned short u16;
typedef __attribute__((ext_vector_type(8))) short bf16x8;
typedef __attribute__((ext_vector_type(4))) short s16x4;
typedef __attribute__((ext_vector_type(16))) float f32x16;
typedef __attribute__((ext_vector_type(4))) unsigned u32x4;
typedef __attribute__((ext_vector_type(2))) float f32x2;
#define DI __device__ __forceinline__
__device__ __forceinline__ int TIDX() { int t = (int)threadIdx.x; asm volatile("" : "+v"(t)); return t; }
#define MFMA32(a, b, c) __builtin_amdgcn_mfma_f32_32x32x16_bf16((a), (b), (c), 0, 0, 0)
#define MFMA16(a, b, c) __builtin_amdgcn_mfma_f32_16x16x32_bf16((a), (b), (c), 0, 0, 0)
typedef __attribute__((ext_vector_type(4))) float f32x4;

constexpr int NT = 256;
constexpr int T_TOK = 32768;
constexpr int SEQ = 8192;
constexpr int DM = 1024;
constexpr float DN_ALPHA = 1.681792830507429f;

constexpr size_t MiB = 1024ull * 1024ull;
constexpr int LDX = 1088;
constexpr int LDW = 1088;
constexpr int LD_SWA = 1280;
constexpr int LD_DIL = 9352;
constexpr int LD_PQ = 2120;
constexpr int LD_Y = 1056;
constexpr int LD_QM = 1608;
constexpr int LD_KVM = 2120;
constexpr size_t OFF_WT_SWA_IN = 0;
constexpr size_t OFF_WT_SWA_OUT = OFF_WT_SWA_IN + 2ull * 1280 * LDW * 2;
constexpr size_t OFF_WT_DIL_IN = OFF_WT_SWA_OUT + 2ull * 1024 * LDW * 2;
constexpr size_t OFF_WT_DIL_OUT = OFF_WT_DIL_IN + 9216ull * LDW * 2;
constexpr size_t OFF_WT_MLA_IN = OFF_WT_DIL_OUT + 1024ull * LDW * 2;
constexpr size_t OFF_WT_MLA_UQ = OFF_WT_MLA_IN + 512ull * LDW * 2;
constexpr size_t OFF_WT_MLA_UKV = OFF_WT_MLA_UQ + 1536ull * 256 * 2;
constexpr size_t OFF_WT_MLA_OUT = OFF_WT_MLA_UKV + 2048ull * 128 * 2;
constexpr size_t OFF_WT_PEER_Q = OFF_WT_MLA_OUT + 1024ull * LDW * 2;
constexpr size_t OFF_KEYS = OFF_WT_PEER_Q + 4ull * 2048 * LDW * 2;
constexpr size_t OFF_WT_END = OFF_KEYS + 4ull * 8 * 2 * 128 * 128 * 2;
constexpr size_t OFF_XF = 56 * MiB;
constexpr size_t OFF_XB = OFF_XF + 128 * MiB;
constexpr size_t OFF_AO = OFF_XB + 68 * MiB;
constexpr size_t OFF_UB = OFF_AO + 68 * MiB;
constexpr size_t OFF_VB = OFF_UB + 32 * MiB;
constexpr size_t OFF_LSE = OFF_VB + 16 * MiB;
constexpr size_t OFF_BIG = OFF_LSE + 6 * MiB;
constexpr size_t WS_NEEDED = OFF_BIG + 585 * MiB;
static_assert(OFF_WT_END <= OFF_XF, "weights overflow");
static_assert((size_t)T_TOK * LD_DIL * 2 <= 585 * MiB, "big overflow");
constexpr size_t BIG_Y = 0;
constexpr size_t BIG_PQ = 192 * MiB;
constexpr size_t BIG_IDX = 384 * MiB;
constexpr size_t BIG_GATE = 416 * MiB;
constexpr size_t BIG_SUE = 448 * MiB;
constexpr size_t OFF_SU = OFF_UB + 16 * MiB;
constexpr size_t OFF_SV = OFF_SU + 65536;
constexpr size_t BIG_CF = 0;
constexpr size_t BIG_CQ = 64 * MiB;
constexpr size_t BIG_CKV = 96 * MiB;
constexpr size_t BIG_KR = 112 * MiB;
constexpr size_t BIG_QM = 128 * MiB;
constexpr size_t BIG_KVM = 256 * MiB;

constexpr size_t OFF_BAR = 960 * MiB;
constexpr size_t WS_TOTAL = OFF_BAR + 65536;
constexpr int SMEM_BYTES = 77824;

struct Params {
  const float* x; const float* rel_bias; const float* ln_g; const float* ln_b;
  const float* swa_w_in; const float* swa_sinks; const float* swa_w_out;
  const float* dil_w_in; const float* dil_w_out;
  const float* mla_w_in; const float* mla_q_norm; const float* mla_w_uq; const float* mla_kv_norm;
  const float* mla_w_ukv; const float* mla_w_out;
  const float* peer_w_q; const float* peer_keys; const float* peer_u; const float* peer_v;
  float* out; char* ws;
};

typedef __bf16 bf16v2 __attribute__((ext_vector_type(2)));
typedef float f32v2 __attribute__((ext_vector_type(2)));
DI unsigned pack2(float a, float b) { f32v2 v = {a, b}; return __builtin_bit_cast(unsigned, __builtin_convertvector(v, bf16v2)); }
DI u16 f2bf(float x) { return (u16)(pack2(x, 0.f) & 0xffffu); }
DI float bf2f(u16 b) { return __uint_as_float(((unsigned)b) << 16); }
DI float bflo(unsigned w) { return __uint_as_float(w << 16); }
DI float bfhi(unsigned w) { return __uint_as_float(w & 0xffff0000u); }
DI int crow(int i, int hh) { return (i & 3) + 8 * (i >> 2) + 4 * hh; }
DI float wave_sum(float v) {
#pragma unroll
  for (int o = 32; o >= 1; o >>= 1) v += __shfl_xor(v, o);
  return v;
}


#define XB_TMO      128
#define XB_XCNT(j)  (256  + 64 * (j))
#define XB_XSUB(j)  (1280 + 64 * (j))
#define XB_XGEN(j)  (2304 + 64 * (j))
#define XB_TOP      3328
#define XB_TOPGEN   3392
#define XCD_BAR_WORDS 3456
#define XB_SPIN_CAP (1u << 18)
#define LAS __attribute__((address_space(3)))
DI unsigned xb_ld(unsigned* p)              { return __hip_atomic_load(p, __ATOMIC_RELAXED, __HIP_MEMORY_SCOPE_AGENT); }
DI unsigned xb_add(unsigned* p, unsigned v) { return __hip_atomic_fetch_add(p, v, __ATOMIC_RELAXED, __HIP_MEMORY_SCOPE_AGENT); }
DI unsigned xb_xcc_id() { return (unsigned)__builtin_amdgcn_s_getreg((3 << 11) | 20) & 0xFu; }
#define XB_SPIN(cond, bar) do { unsigned _sp = 0; while (cond) { __builtin_amdgcn_s_sleep(1); \
    if ((++_sp & 255u) == 0u) { if (xb_ld(&(bar)[XB_TMO])) break; if (_sp > XB_SPIN_CAP) { atomicAdd(&(bar)[XB_TMO], 1u); break; } } } } while (0)
struct XcdBarrier { unsigned* bar; unsigned x; volatile LAS unsigned* st; };
DI XcdBarrier xcd_barrier_post(unsigned* bar, volatile LAS unsigned* st) {
  XcdBarrier b; b.bar = bar; b.x = xb_xcc_id(); b.st = st;
  if (TIDX() == 0) (void)xb_add(&bar[XB_XCNT(b.x)], 1u);
  return b;
}
DI void xcd_barrier_complete(unsigned* bar, unsigned x, unsigned& nloc, unsigned& nx) {
  const unsigned G = gridDim.x * gridDim.y * gridDim.z;
  unsigned sum, cnt, mine, sp = 0u;
  for (;;) {
    sum = 0u; cnt = 0u; mine = 0u;
#pragma unroll
    for (unsigned j = 0; j < 16; ++j) { const unsigned c = xb_ld(&bar[XB_XCNT(j)]); sum += c; cnt += (c > 0u) ? 1u : 0u; mine = (j == x) ? c : mine; }
    if (sum == G) break;
    __builtin_amdgcn_s_sleep(1);
    if ((++sp & 255u) == 0u) { if (xb_ld(&bar[XB_TMO])) break; if (sp > XB_SPIN_CAP) { atomicAdd(&bar[XB_TMO], 1u); break; } }
  }
  nloc = mine > 0u ? mine : 1u; nx = cnt > 0u ? cnt : 1u;
}
__shared__ uint4 g_xb_words;
DI void xcd_barrier(const XcdBarrier& b);
DI void xcd_barrier2(unsigned* bar) {
  XcdBarrier b; b.bar = bar; b.x = xb_xcc_id(); b.st = (volatile LAS unsigned*)&g_xb_words;
  xcd_barrier(b);
}
DI void xcd_barrier(const XcdBarrier& b) {
  asm volatile("s_waitcnt vmcnt(0)" ::: "memory");
  __syncthreads();
  if (TIDX() == 0) {
    unsigned* bar = b.bar;
    __builtin_amdgcn_s_waitcnt(0);
    unsigned nloc = b.st[0], nx = b.st[1];
    if (nloc == 0u) { xcd_barrier_complete(bar, b.x, nloc, nx); b.st[0] = nloc; b.st[1] = nx; }
    const unsigned old = xb_add(&bar[XB_XSUB(b.x)], 1u);
    const unsigned gen = old / nloc;
    if (old + 1u == (gen + 1u) * nloc) {
      __builtin_amdgcn_fence(__ATOMIC_RELEASE, "agent");
      asm volatile("s_waitcnt vmcnt(0)" ::: "memory");
      const unsigned og = xb_add(&bar[XB_TOP], 1u);
      const unsigned tg = og / nx;
      if (og + 1u == (tg + 1u) * nx) xb_add(&bar[XB_TOPGEN], 1u);
      else XB_SPIN(xb_ld(&bar[XB_TOPGEN]) == tg, bar);
      __builtin_amdgcn_fence(__ATOMIC_ACQUIRE, "agent");
      xb_add(&bar[XB_XGEN(b.x)], 1u);
      asm volatile("s_waitcnt vmcnt(0)" ::: "memory");
    } else {
      XB_SPIN(xb_ld(&bar[XB_XGEN(b.x)]) == gen, bar);
      __builtin_amdgcn_fence(__ATOMIC_ACQUIRE, "agent");
      asm volatile("s_waitcnt vmcnt(0)" ::: "memory");
    }
  }
  __syncthreads();
}

DI void transpose_convert(const float* W, u16* Wt, int K, int N, int ldt, char* smem) {
  float (*tile)[33] = (float (*)[33])smem;
  const int tilesN = N / 32, tilesK = K / 64;
  const int tx = TIDX() & 31, ty = TIDX() >> 5;
  for (int t = blockIdx.x; t < tilesK * tilesN; t += gridDim.x) {
    const int tk = t / tilesN, tn = t % tilesN;
#pragma unroll
    for (int i = 0; i < 8; i++) tile[ty + 8 * i][tx] = W[(size_t)(tk * 64 + ty + 8 * i) * N + tn * 32 + tx];
    __syncthreads();
#pragma unroll
    for (int i = 0; i < 4; i++) {
      const int n = ty + 8 * i;
      *(unsigned*)(Wt + (size_t)(tn * 32 + n) * ldt + tk * 64 + 2 * tx) = pack2(tile[2 * tx][n], tile[2 * tx + 1][n]);
    }
    __syncthreads();
  }
}
DI void convert_f32_bf16(const float* src, u16* dst, size_t n) {
  const size_t n8 = n / 8;
  for (size_t i = (size_t)blockIdx.x * NT + TIDX(); i < n8; i += (size_t)gridDim.x * NT) {
    const float4 a = ((const float4*)src)[2 * i], b = ((const float4*)src)[2 * i + 1];
    uint4 o; o.x = pack2(a.x, a.y); o.y = pack2(a.z, a.w); o.z = pack2(b.x, b.y); o.w = pack2(b.z, b.w);
    ((uint4*)dst)[i] = o;
  }
}


DI void convert_rows_bf16(const float* src, u16* dst, int rows, int ldd) {
  const size_t n8 = (size_t)rows * 128;
  for (size_t i = (size_t)blockIdx.x * NT + TIDX(); i < n8; i += (size_t)gridDim.x * NT) {
    const size_t row = i >> 7; const int c = (int)(i & 127);
    const float4 a = ((const float4*)src)[2 * i], b = ((const float4*)src)[2 * i + 1];
    uint4 o; o.x = pack2(a.x, a.y); o.y = pack2(a.z, a.w); o.z = pack2(b.x, b.y); o.w = pack2(b.z, b.w);
    *(uint4*)(dst + row * ldd + c * 8) = o;
  }
}
DI void convert_rows_fp8(const float* src, unsigned char* dst, float* dq, int nrows) {
  const int lane = TIDX() & 63, wave = TIDX() >> 6;
  for (int row = blockIdx.x * 4 + wave; row < nrows; row += gridDim.x * 4) {
    const float4* sp = (const float4*)(src + (size_t)row * 1024 + lane * 16);
    const float4 a = sp[0], b = sp[1], c = sp[2], d = sp[3];
    float m = fmaxf(fmaxf(fmaxf(fabsf(a.x), fabsf(a.y)), fmaxf(fabsf(a.z), fabsf(a.w))), fmaxf(fmaxf(fabsf(b.x), fabsf(b.y)), fmaxf(fabsf(b.z), fabsf(b.w))));
    m = fmaxf(m, fmaxf(fmaxf(fmaxf(fabsf(c.x), fabsf(c.y)), fmaxf(fabsf(c.z), fabsf(c.w))), fmaxf(fmaxf(fabsf(d.x), fabsf(d.y)), fmaxf(fabsf(d.z), fabsf(d.w)))));
#pragma unroll
    for (int o = 32; o >= 1; o >>= 1) m = fmaxf(m, __shfl_xor(m, o));
    const float sc = (m > 0.f) ? 448.f / m : 1.f;
    u32x4 o;
    int w;
    w = 0; w = __builtin_amdgcn_cvt_pk_fp8_f32(a.x * sc, a.y * sc, w, false); w = __builtin_amdgcn_cvt_pk_fp8_f32(a.z * sc, a.w * sc, w, true); o[0] = (unsigned)w;
    w = 0; w = __builtin_amdgcn_cvt_pk_fp8_f32(b.x * sc, b.y * sc, w, false); w = __builtin_amdgcn_cvt_pk_fp8_f32(b.z * sc, b.w * sc, w, true); o[1] = (unsigned)w;
    w = 0; w = __builtin_amdgcn_cvt_pk_fp8_f32(c.x * sc, c.y * sc, w, false); w = __builtin_amdgcn_cvt_pk_fp8_f32(c.z * sc, c.w * sc, w, true); o[2] = (unsigned)w;
    w = 0; w = __builtin_amdgcn_cvt_pk_fp8_f32(d.x * sc, d.y * sc, w, false); w = __builtin_amdgcn_cvt_pk_fp8_f32(d.z * sc, d.w * sc, w, true); o[3] = (unsigned)w;
    *(u32x4*)(dst + (size_t)row * 1024 + lane * 16) = o;
    if (lane == 0) dq[row] = (m > 0.f) ? m * (1.f / 448.f) : 1.f;
  }
}

typedef __attribute__((ext_vector_type(2))) unsigned u32x2;
DI void convert_rows_fp4(const float* src, unsigned char* dst, float* dq, int nrows) {
  const int lane = TIDX() & 63, wave = TIDX() >> 6;
  for (int row = blockIdx.x * 4 + wave; row < nrows; row += gridDim.x * 4) {
    const float4* sp = (const float4*)(src + (size_t)row * 1024 + lane * 16);
    const float4 a = sp[0], b = sp[1], c = sp[2], d = sp[3];
    float m = fmaxf(fmaxf(fmaxf(fabsf(a.x), fabsf(a.y)), fmaxf(fabsf(a.z), fabsf(a.w))), fmaxf(fmaxf(fabsf(b.x), fabsf(b.y)), fmaxf(fabsf(b.z), fabsf(b.w))));
    m = fmaxf(m, fmaxf(fmaxf(fmaxf(fabsf(c.x), fabsf(c.y)), fmaxf(fabsf(c.z), fabsf(c.w))), fmaxf(fmaxf(fabsf(d.x), fabsf(d.y)), fmaxf(fabsf(d.z), fabsf(d.w)))));
#pragma unroll
    for (int o = 32; o >= 1; o >>= 1) m = fmaxf(m, __shfl_xor(m, o));
    const float sc = (m > 0.f) ? 6.f / m : 1.f;
    unsigned w0 = 0, w1 = 0;
    w0 = __builtin_amdgcn_cvt_scalef32_pk_fp4_f32(w0, a.x * sc, a.y * sc, 1.0f, 0);
    w0 = __builtin_amdgcn_cvt_scalef32_pk_fp4_f32(w0, a.z * sc, a.w * sc, 1.0f, 1);
    w0 = __builtin_amdgcn_cvt_scalef32_pk_fp4_f32(w0, b.x * sc, b.y * sc, 1.0f, 2);
    w0 = __builtin_amdgcn_cvt_scalef32_pk_fp4_f32(w0, b.z * sc, b.w * sc, 1.0f, 3);
    w1 = __builtin_amdgcn_cvt_scalef32_pk_fp4_f32(w1, c.x * sc, c.y * sc, 1.0f, 0);
    w1 = __builtin_amdgcn_cvt_scalef32_pk_fp4_f32(w1, c.z * sc, c.w * sc, 1.0f, 1);
    w1 = __builtin_amdgcn_cvt_scalef32_pk_fp4_f32(w1, d.x * sc, d.y * sc, 1.0f, 2);
    w1 = __builtin_amdgcn_cvt_scalef32_pk_fp4_f32(w1, d.z * sc, d.w * sc, 1.0f, 3);
    u32x2 o; o[0] = w0; o[1] = w1;
    *(u32x2*)(dst + (size_t)row * 512 + lane * 8) = o;
    if (lane == 0) dq[row] = (m > 0.f) ? m * (1.f / 6.f) : 1.f;
  }
}

template <class Epi>
DI void gemm_phase(const u16* A, int lda, const u16* Bt, int ldb, int M, int Npad, int K, char* smem, Epi epi) {
  const int tilesN = Npad / 128, tilesM = M / 128;
  const int tid = TIDX(), lane = tid & 63, wave = tid >> 6, r = lane & 31, hh = lane >> 5;
  const int wm = wave >> 1, wn = wave & 1, l15 = lane & 15, lq = lane >> 4;
  char* As = smem; char* Bs = smem + 128 * 144;
  const int nk = K / 64;
  const int xcd = blockIdx.x & 7, local = blockIdx.x >> 3, nloc = gridDim.x >> 3;
  const int ulim = (tilesM >> 3) * tilesN;
  u32x4 ra0[4], rb0[4];
  if (local < ulim) {
    const u16* Ag = A + (size_t)(((local / tilesN) * 8 + xcd) * 128) * lda;
    const u16* Bg = Bt + (size_t)((local % tilesN) * 128) * ldb;
#pragma unroll
    for (int i = 0; i < 4; i++) { const int c = tid + 256 * i, row = c >> 3, kc = c & 7;
      ra0[i] = *(const u32x4*)(Ag + (size_t)row * lda + kc * 8); rb0[i] = *(const u32x4*)(Bg + (size_t)row * ldb + kc * 8); }
  }
  for (int u = local; u < ulim; u += nloc) {
    const int tm = (u / tilesN) * 8 + xcd, tn = u % tilesN;
    const int un = u + nloc;
    const u16* Agn = A + (size_t)((((un < ulim ? un : u) / tilesN) * 8 + xcd) * 128) * lda;
    const u16* Bgn = Bt + (size_t)(((un < ulim ? un : u) % tilesN) * 128) * ldb;
    f32x4 acc[4][4];
#pragma unroll
    for (int a = 0; a < 4; a++)
#pragma unroll
      for (int b = 0; b < 4; b++)
#pragma unroll
        for (int i = 0; i < 4; i++) acc[a][b][i] = 0.f;
    const u16* Ag = A + (size_t)(tm * 128) * lda;
    const u16* Bg = Bt + (size_t)(tn * 128) * ldb;
#define GLOAD(RA, RB, K0) _Pragma("unroll") for (int i = 0; i < 4; i++) { const int c = tid + 256 * i, row = c >> 3, kc = c & 7; \
      RA[i] = *(const u32x4*)(Ag + (size_t)row * lda + (K0) + kc * 8); RB[i] = *(const u32x4*)(Bg + (size_t)row * ldb + (K0) + kc * 8); }
#define LWRITE(RA, RB, BUF) _Pragma("unroll") for (int i = 0; i < 4; i++) { const int c = tid + 256 * i, row = c >> 3, kc = c & 7; \
      *(u32x4*)(As + (BUF) * 36864 + row * 144 + kc * 16) = RA[i]; *(u32x4*)(Bs + (BUF) * 36864 + row * 144 + kc * 16) = RB[i]; }
#define COMPUTE(BUF) _Pragma("unroll") for (int s = 0; s < 2; s++) { bf16x8 af[4], bfr[4]; \
      _Pragma("unroll") for (int mi = 0; mi < 4; mi++) af[mi] = *(const bf16x8*)(As + (BUF) * 36864 + (wm * 64 + mi * 16 + l15) * 144 + (s * 32 + lq * 8) * 2); \
      _Pragma("unroll") for (int ni = 0; ni < 4; ni++) bfr[ni] = *(const bf16x8*)(Bs + (BUF) * 36864 + (wn * 64 + ni * 16 + l15) * 144 + (s * 32 + lq * 8) * 2); \
      _Pragma("unroll") for (int mi = 0; mi < 4; mi++) _Pragma("unroll") for (int ni = 0; ni < 4; ni++) acc[mi][ni] = MFMA16(bfr[ni], af[mi], acc[mi][ni]); }
    LWRITE(ra0, rb0, 0);
    GLOAD(ra0, rb0, 64);
    __syncthreads();
    for (int kt = 0; kt < nk; kt++) {
      const int cb = kt & 1;
      if (kt + 1 < nk) LWRITE(ra0, rb0, (cb ^ 1));
      if (kt + 2 < nk) { GLOAD(ra0, rb0, (kt + 2) * 64); }
      else if (kt + 2 == nk && un < ulim) {
#pragma unroll
        for (int i = 0; i < 4; i++) { const int c = tid + 256 * i, row = c >> 3, kc = c & 7;
          ra0[i] = *(const u32x4*)(Agn + (size_t)row * lda + kc * 8); rb0[i] = *(const u32x4*)(Bgn + (size_t)row * ldb + kc * 8); }
      }
      __builtin_amdgcn_s_setprio(1);
      COMPUTE(cb);
      __builtin_amdgcn_s_setprio(0);
      __syncthreads();
    }
#undef GLOAD
#undef LWRITE
#undef COMPUTE
    if (Epi::STAGED) {
      char* Cs = smem;
#pragma unroll
      for (int mi = 0; mi < 4; mi++)
#pragma unroll
        for (int ni = 0; ni < 4; ni++) {
          u32x2 o; o[0] = pack2(acc[mi][ni][0], acc[mi][ni][1]); o[1] = pack2(acc[mi][ni][2], acc[mi][ni][3]);
          *(u32x2*)(Cs + (wm * 64 + mi * 16 + l15) * 272 + (wn * 64 + ni * 16 + lq * 4) * 2) = o;
        }
      __syncthreads();
#pragma unroll
      for (int i = 0; i < 8; i++) {
        const int c = tid + 256 * i, row = c >> 4, ch = c & 15;
        const u32x4 v = *(const u32x4*)(Cs + row * 272 + ch * 16);
        epi.store16(tm * 128 + row, tn * 128 + ch * 8, v);
      }
      __syncthreads();
    } else {
#pragma unroll
      for (int mi = 0; mi < 4; mi++)
#pragma unroll
        for (int ni = 0; ni < 4; ni++) {
          const int row = tm * 128 + wm * 64 + mi * 16 + l15;
          const int col = tn * 128 + wn * 64 + ni * 16 + lq * 4;
          epi(row, col, acc[mi][ni][0], acc[mi][ni][1], acc[mi][ni][2], acc[mi][ni][3]);
        }
    }
  }
}
struct EpiBf16 {
  static constexpr bool STAGED = true;
  u16* C; int ldc; int N;
  DI void store16(int row, int col, u32x4 v) const { if (col < N) *(u32x4*)(C + (size_t)row * ldc + col) = v; }
  DI void operator()(int row, int col, float a, float b, float c, float d) const {
    if (col < N) { uint2 o; o.x = pack2(a, b); o.y = pack2(c, d); *(uint2*)(C + (size_t)row * ldc + col) = o; }
  }
};
struct EpiF32 {
  static constexpr bool STAGED = false;
  float* C; int ldc; int N;
  DI void store16(int, int, u32x4) const {}
  DI void operator()(int row, int col, float a, float b, float c, float d) const {
    if (col < N) { float4 o = {a, b, c, d}; *(float4*)(C + (size_t)row * ldc + col) = o; }
  }
};

struct AttnState { f32x16 o[2]; float m, l; };
DI void attn_init(AttnState& st) {
#pragma unroll
  for (int i = 0; i < 16; i++) { st.o[0][i] = 0.f; st.o[1][i] = 0.f; }
  st.m = -1e30f; st.l = 0.f;
}
template <int KS, int KSTR, int VSTR, bool MASKED, class L>
DI void attn_step(AttnState& st, const bf16x8* qf, const char* Kb, const char* Vb, int lane, L logit) {
  const int r = lane & 31, hh = lane >> 5;
  f32x16 s;
#pragma unroll
  for (int i = 0; i < 16; i++) s[i] = 0.f;
#pragma unroll
  for (int ks = 0; ks < KS; ks++) {
    const bf16x8 a = *(const bf16x8*)(Kb + r * KSTR + (ks * 16 + hh * 8) * 2);
    s = MFMA32(a, qf[ks], s);
  }
  float mx = -1e30f;
  bool vld[16];
#pragma unroll
  for (int i = 0; i < 16; i++) {
    bool v = true;
    const float val = logit(i, s[i], v);
    if (MASKED) { vld[i] = v; s[i] = val; if (v) mx = fmaxf(mx, val); }
    else { s[i] = val; mx = fmaxf(mx, val); }
  }
  mx = fmaxf(mx, __shfl_xor(mx, 32));
  const float mnew = fmaxf(st.m, mx);
  const float alpha = __builtin_amdgcn_exp2f(st.m - mnew);
  float ps = 0.f;
#pragma unroll
  for (int i = 0; i < 16; i++) {
    float p = __builtin_amdgcn_exp2f(s[i] - mnew);
    if (MASKED) p = vld[i] ? p : 0.f;
    s[i] = p; ps += p;
  }
  st.l = st.l * alpha + ps;
  st.m = mnew;
  if (__any(alpha != 1.f)) {
#pragma unroll
    for (int i = 0; i < 16; i++) { st.o[0][i] *= alpha; st.o[1][i] *= alpha; }
  }
  bf16x8 pf[2];
#pragma unroll
  for (int s2 = 0; s2 < 2; s2++) {
    union { bf16x8 v; unsigned u[4]; } pk;
#pragma unroll
    for (int j = 0; j < 4; j++) pk.u[j] = pack2(s[8 * s2 + 2 * j], s[8 * s2 + 2 * j + 1]);
    pf[s2] = pk.v;
  }
  const int i16 = lane & 15, q = i16 >> 2, p4 = i16 & 3, rhalf = (lane >> 4) & 1;
#pragma unroll
  for (int s2 = 0; s2 < 2; s2++) {
#pragma unroll
    for (int blk = 0; blk < 2; blk++) {
      const char* a0 = Vb + (16 * s2 + 4 * hh + q) * VSTR + (blk * 32 + rhalf * 16 + 4 * p4) * 2;
      const s16x4 lo = __builtin_amdgcn_ds_read_tr16_b64_v4i16((s16x4 __attribute__((address_space(3)))*)(a0));
      const s16x4 hi = __builtin_amdgcn_ds_read_tr16_b64_v4i16((s16x4 __attribute__((address_space(3)))*)(a0 + 8 * VSTR));
      const bf16x8 vf = __builtin_shufflevector(lo, hi, 0, 1, 2, 3, 4, 5, 6, 7);
      st.o[blk] = MFMA32(vf, pf[s2], st.o[blk]);
    }
  }
}
template <int KS, int KSTR, int VSTR>
DI void attn_step_raw(AttnState& st, const bf16x8* qf, const char* Kb, const char* Vb, int lane, float sc) {
  const int r = lane & 31, hh = lane >> 5;
  f32x16 s;
#pragma unroll
  for (int i = 0; i < 16; i++) s[i] = 0.f;
#pragma unroll
  for (int ks = 0; ks < KS; ks++) {
    const bf16x8 a = *(const bf16x8*)(Kb + r * KSTR + (ks * 16 + hh * 8) * 2);
    s = MFMA32(a, qf[ks], s);
  }
  float mx = s[0];
#pragma unroll
  for (int i = 1; i < 16; i++) mx = fmaxf(mx, s[i]);
  mx = fmaxf(mx, __shfl_xor(mx, 32));
  const float mnew = fmaxf(st.m, mx * sc);
  const float alpha = __builtin_amdgcn_exp2f(st.m - mnew);
  float ps = 0.f;
#pragma unroll
  for (int i = 0; i < 16; i++) { const float p = __builtin_amdgcn_exp2f(__builtin_fmaf(s[i], sc, -mnew)); s[i] = p; ps += p; }
  st.l = st.l * alpha + ps;
  st.m = mnew;
  if (__any(alpha != 1.f)) {
#pragma unroll
    for (int i = 0; i < 16; i++) { st.o[0][i] *= alpha; st.o[1][i] *= alpha; }
  }
  bf16x8 pf[2];
#pragma unroll
  for (int s2 = 0; s2 < 2; s2++) {
    union { bf16x8 v; unsigned u[4]; } pk;
#pragma unroll
    for (int j = 0; j < 4; j++) pk.u[j] = pack2(s[8 * s2 + 2 * j], s[8 * s2 + 2 * j + 1]);
    pf[s2] = pk.v;
  }
  const int i16 = lane & 15, q = i16 >> 2, p4 = i16 & 3, rhalf = (lane >> 4) & 1;
#pragma unroll
  for (int s2 = 0; s2 < 2; s2++) {
#pragma unroll
    for (int blk = 0; blk < 2; blk++) {
      const char* a0 = Vb + (16 * s2 + 4 * hh + q) * VSTR + (blk * 32 + rhalf * 16 + 4 * p4) * 2;
      const s16x4 lo = __builtin_amdgcn_ds_read_tr16_b64_v4i16((s16x4 __attribute__((address_space(3)))*)(a0));
      const s16x4 hi = __builtin_amdgcn_ds_read_tr16_b64_v4i16((s16x4 __attribute__((address_space(3)))*)(a0 + 8 * VSTR));
      const bf16x8 vf = __builtin_shufflevector(lo, hi, 0, 1, 2, 3, 4, 5, 6, 7);
      st.o[blk] = MFMA32(vf, pf[s2], st.o[blk]);
    }
  }
}
template <int KS, int KSTR, int VSTR>
DI void attn_step_raw2(AttnState& sa, AttnState& sb, const bf16x8* qfa, const bf16x8* qfb, const char* Kb, const char* Vb, int lane, float sc) {
  const int r = lane & 31, hh = lane >> 5;
  f32x16 xa, xb;
#pragma unroll
  for (int i = 0; i < 16; i++) { xa[i] = 0.f; xb[i] = 0.f; }
#pragma unroll
  for (int ks = 0; ks < KS; ks++) {
    const bf16x8 a = *(const bf16x8*)(Kb + r * KSTR + (ks * 16 + hh * 8) * 2);
    xa = MFMA32(a, qfa[ks], xa);
    xb = MFMA32(a, qfb[ks], xb);
  }
  float ma = xa[0], mb = xb[0];
#pragma unroll
  for (int i = 1; i < 16; i++) { ma = fmaxf(ma, xa[i]); mb = fmaxf(mb, xb[i]); }
  ma = fmaxf(ma, __shfl_xor(ma, 32)); mb = fmaxf(mb, __shfl_xor(mb, 32));
  const float na = fmaxf(sa.m, ma * sc), nb = fmaxf(sb.m, mb * sc);
  const float aa = __builtin_amdgcn_exp2f(sa.m - na), ab = __builtin_amdgcn_exp2f(sb.m - nb);
  float pa = 0.f, pb = 0.f;
#pragma unroll
  for (int i = 0; i < 16; i++) {
    const float u = __builtin_amdgcn_exp2f(__builtin_fmaf(xa[i], sc, -na)); xa[i] = u; pa += u;
    const float v = __builtin_amdgcn_exp2f(__builtin_fmaf(xb[i], sc, -nb)); xb[i] = v; pb += v;
  }
  sa.l = sa.l * aa + pa; sa.m = na;
  sb.l = sb.l * ab + pb; sb.m = nb;
  if (__any(aa != 1.f)) {
#pragma unroll
    for (int i = 0; i < 16; i++) { sa.o[0][i] *= aa; sa.o[1][i] *= aa; }
  }
  if (__any(ab != 1.f)) {
#pragma unroll
    for (int i = 0; i < 16; i++) { sb.o[0][i] *= ab; sb.o[1][i] *= ab; }
  }
  bf16x8 pfa[2], pfb[2];
#pragma unroll
  for (int s2 = 0; s2 < 2; s2++) {
    union { bf16x8 v; unsigned u[4]; } ka, kb;
#pragma unroll
    for (int j = 0; j < 4; j++) { ka.u[j] = pack2(xa[8 * s2 + 2 * j], xa[8 * s2 + 2 * j + 1]); kb.u[j] = pack2(xb[8 * s2 + 2 * j], xb[8 * s2 + 2 * j + 1]); }
    pfa[s2] = ka.v; pfb[s2] = kb.v;
  }
  const int i16 = lane & 15, q = i16 >> 2, p4 = i16 & 3, rhalf = (lane >> 4) & 1;
#pragma unroll
  for (int s2 = 0; s2 < 2; s2++) {
#pragma unroll
    for (int blk = 0; blk < 2; blk++) {
      const char* a0 = Vb + (16 * s2 + 4 * hh + q) * VSTR + (blk * 32 + rhalf * 16 + 4 * p4) * 2;
      const s16x4 lo = __builtin_amdgcn_ds_read_tr16_b64_v4i16((s16x4 __attribute__((address_space(3)))*)(a0));
      const s16x4 hi = __builtin_amdgcn_ds_read_tr16_b64_v4i16((s16x4 __attribute__((address_space(3)))*)(a0 + 8 * VSTR));
      const bf16x8 vf = __builtin_shufflevector(lo, hi, 0, 1, 2, 3, 4, 5, 6, 7);
      sa.o[blk] = MFMA32(vf, pfa[s2], sa.o[blk]);
      sb.o[blk] = MFMA32(vf, pfb[s2], sb.o[blk]);
    }
  }
}
DI void attn_final(AttnState& st, float& inv_l, float& lse) {
  const float lt = st.l + __shfl_xor(st.l, 32);
  inv_l = 1.f / lt;
  lse = st.m * 0.6931471805599453f + __logf(lt);
}
DI void attn_store(const AttnState& st, u16* dstrow, float sc, int hh) {
#pragma unroll
  for (int blk = 0; blk < 2; blk++)
#pragma unroll
    for (int g = 0; g < 4; g++) {
      uint2 o;
      o.x = pack2(st.o[blk][4 * g] * sc, st.o[blk][4 * g + 1] * sc);
      o.y = pack2(st.o[blk][4 * g + 2] * sc, st.o[blk][4 * g + 3] * sc);
      *(uint2*)(dstrow + blk * 32 + 8 * g + 4 * hh) = o;
    }
}

DI int rel_bucket(int n) {
  if (n < 16) return n;
  const float nf = (float)n;
  int large = 16 + (int)(logf(nf / 16.f) / 4.852030263919617f * 16.f);
  return large < 31 ? large : 31;
}

DI void band_tile(const u16* Q, const u16* Kc, const u16* Vc, size_t rs, bool has_prev, int dil, int max_dist,
                  const float* rel_bias, int head, u16* O, size_t ors, float* lse_out, size_t lse_stride,
                  bool use_sink, float sink, char* smem) {
  const int tid = TIDX(), lane = tid & 63, w = tid >> 6, r = lane & 31, hh = lane >> 5;
  char* Ks = smem; char* Vs = smem + 256 * 144; float* biasd = (float*)(smem + 2 * 256 * 144);
#pragma unroll
  for (int i = 0; i < 8; i++) {
    const int c = tid + 256 * i, row = c >> 3, ch = c & 7;
    if (row >= 128 || has_prev) {
      const ptrdiff_t off = (ptrdiff_t)(row - 128) * (ptrdiff_t)rs + ch * 8;
      *(u32x4*)(Ks + row * 144 + ch * 16) = *(const u32x4*)(Kc + off);
      *(u32x4*)(Vs + row * 144 + ch * 16) = *(const u32x4*)(Vc + off);
    }
  }
  if (tid < 129) biasd[tid] = rel_bias[rel_bucket(tid * dil) * 16 + head] * 1.4426950408889634f;
  bf16x8 qf[4];
  const u16* qrow = Q + (size_t)(32 * w + r) * rs;
#pragma unroll
  for (int ks = 0; ks < 4; ks++) qf[ks] = *(const bf16x8*)(qrow + ks * 16 + hh * 8);
  __syncthreads();
  AttnState st; attn_init(st);
  const int qi = 32 * w + r;
  for (int kt = 0; kt < 5; kt++) {
    const int kwin = 32 * (w + kt);
    if (!has_prev && kwin < 128) continue;
    if (kt == 0 || kt == 4) {
      attn_step<4, 144, 144, true>(st, qf, Ks + kwin * 144, Vs + kwin * 144, lane,
        [&](int i, float raw, bool& v) -> float {
          const int kj = kwin + crow(i, hh);
          const int dist = 128 + qi - kj;
          v = (dist >= 0) && (dist <= max_dist);
          const int dc = dist < 0 ? 0 : (dist > 128 ? 128 : dist);
          return raw * (0.125f * 1.4426950408889634f) + biasd[dc];
        });
    } else {
      attn_step<4, 144, 144, false>(st, qf, Ks + kwin * 144, Vs + kwin * 144, lane,
        [&](int i, float raw, bool& v) -> float {
          const int dist = 128 + qi - (kwin + crow(i, hh));
          return raw * (0.125f * 1.4426950408889634f) + biasd[dist];
        });
    }
  }
  float inv_l, lse; attn_final(st, inv_l, lse);
  float sc = inv_l;
  if (use_sink) sc *= 1.f / (1.f + __expf(-(lse - sink)));
  attn_store(st, O + (size_t)qi * ors, sc, hh);
  if (lse_out && hh == 0) lse_out[(size_t)qi * lse_stride] = lse;
  __syncthreads();
}

DI void phase_prep(const Params& p, char* smem) {
  char* ws = p.ws;
  for (int j = 0; j < 2; j++) {
    transpose_convert(p.swa_w_in + (size_t)j * 1024 * 1280, (u16*)(ws + OFF_WT_SWA_IN) + (size_t)j * 1280 * LDW, 1024, 1280, LDW, smem);
    transpose_convert(p.swa_w_out + (size_t)j * 1024 * 1024, (u16*)(ws + OFF_WT_SWA_OUT) + (size_t)j * 1024 * LDW, 1024, 1024, LDW, smem);
  }
  transpose_convert(p.dil_w_in, (u16*)(ws + OFF_WT_DIL_IN), 1024, 9216, LDW, smem);
  transpose_convert(p.dil_w_out, (u16*)(ws + OFF_WT_DIL_OUT), 1024, 1024, LDW, smem);
  transpose_convert(p.mla_w_in, (u16*)(ws + OFF_WT_MLA_IN), 1024, 416, LDW, smem);
  transpose_convert(p.mla_w_uq, (u16*)(ws + OFF_WT_MLA_UQ), 256, 1536, 256, smem);
  transpose_convert(p.mla_w_ukv, (u16*)(ws + OFF_WT_MLA_UKV), 128, 2048, 128, smem);
  transpose_convert(p.mla_w_out, (u16*)(ws + OFF_WT_MLA_OUT), 1024, 1024, LDW, smem);
  for (int j = 0; j < 4; j++)
    transpose_convert(p.peer_w_q + (size_t)j * 1024 * 2048, (u16*)(ws + OFF_WT_PEER_Q) + (size_t)j * 2048 * LDW, 1024, 2048, LDW, smem);
  {
    uint4* z = (uint4*)((u16*)(ws + OFF_WT_MLA_IN) + 416ull * LDW);
    const size_t n = 96ull * LDW * 2 / 16;
    for (size_t i = (size_t)blockIdx.x * NT + TIDX(); i < n; i += (size_t)gridDim.x * NT) z[i] = make_uint4(0, 0, 0, 0);
  }
  convert_f32_bf16(p.peer_keys, (u16*)(ws + OFF_KEYS), 4ull * 8 * 2 * 128 * 128);
  convert_rows_bf16(p.x, (u16*)(ws + OFF_XB), T_TOK, LDX);
}

DI void phase_inproj(const Params& p, int L, char* smem) {
  char* ws = p.ws;
  const int kind = L % 3, j = L / 3;
  const u16* XB = (const u16*)(ws + OFF_XB);
  if (kind == 0) {
    EpiBf16 e{(u16*)(ws + OFF_BIG), LD_SWA, 1280};
    gemm_phase(XB, LDX, (const u16*)(ws + OFF_WT_SWA_IN) + (size_t)j * 1280 * LDW, LDW, T_TOK, 1280, 1024, smem, e);
  } else if (kind == 1) {
    EpiBf16 e{(u16*)(ws + OFF_BIG), LD_DIL, 9216};
    gemm_phase(XB, LDX, (const u16*)(ws + OFF_WT_DIL_IN), LDW, T_TOK, 9216, 1024, smem, e);
  } else {
    EpiF32 e{(float*)(ws + OFF_BIG + BIG_CF), 416, 416};
    gemm_phase(XB, LDX, (const u16*)(ws + OFF_WT_MLA_IN), LDW, T_TOK, 512, 1024, smem, e);
  }
  convert_rows_fp4(p.peer_u + (size_t)L * 16384 * 1024, (unsigned char*)(ws + OFF_UB), (float*)(ws + OFF_SU), 16384);
  convert_rows_fp4(p.peer_v + (size_t)L * 16384 * 1024, (unsigned char*)(ws + OFF_VB), (float*)(ws + OFF_SV), 16384);
}

DI void phase_mla_norm(const Params& p, char* smem) {
  char* ws = p.ws;
  const float* CF = (const float*)(ws + OFF_BIG + BIG_CF);
  u16* CQ = (u16*)(ws + OFF_BIG + BIG_CQ); u16* CKV = (u16*)(ws + OFF_BIG + BIG_CKV); u16* KR = (u16*)(ws + OFF_BIG + BIG_KR);
  const int lane = TIDX() & 63, wave = TIDX() >> 6;
  for (int t = blockIdx.x * 4 + wave; t < T_TOK; t += gridDim.x * 4) {
    const float* c = CF + (size_t)t * 416;
    const float4 cq = *(const float4*)(c + lane * 4);
    const float2 ckv = *(const float2*)(c + 256 + lane * 2);
    float sq = cq.x * cq.x + cq.y * cq.y + cq.z * cq.z + cq.w * cq.w;
    float skv = ckv.x * ckv.x + ckv.y * ckv.y;
    sq = wave_sum(sq); skv = wave_sum(skv);
    const float rq = rsqrtf(sq * (1.f / 256.f) + 1e-6f), rkv = rsqrtf(skv * (1.f / 128.f) + 1e-6f);
    const float4 gq = *(const float4*)(p.mla_q_norm + lane * 4);
    const float2 gkv = *(const float2*)(p.mla_kv_norm + lane * 2);
    uint2 oq; oq.x = pack2(cq.x * rq * gq.x, cq.y * rq * gq.y); oq.y = pack2(cq.z * rq * gq.z, cq.w * rq * gq.w);
    *(uint2*)(CQ + (size_t)t * 256 + lane * 4) = oq;
    *(unsigned*)(CKV + (size_t)t * 128 + lane * 2) = pack2(ckv.x * rkv * gkv.x, ckv.y * rkv * gkv.y);
    if (lane < 16) {
      const float t1 = c[384 + lane], t2 = c[384 + 16 + lane];
      const float freq = powf(10000.f, -(float)lane / 16.f);
      const float ang = (float)(t % SEQ) * freq;
      float sn, cs; sincosf(ang, &sn, &cs);
      KR[(size_t)t * 32 + lane] = f2bf(t1 * cs - t2 * sn);
      KR[(size_t)t * 32 + 16 + lane] = f2bf(t1 * sn + t2 * cs);
    }
  }
}
DI void phase_mla_up(const Params& p, char* smem) {
  char* ws = p.ws;
  EpiBf16 e1{(u16*)(ws + OFF_BIG + BIG_QM), LD_QM, 1536};
  gemm_phase((const u16*)(ws + OFF_BIG + BIG_CQ), 256, (const u16*)(ws + OFF_WT_MLA_UQ), 256, T_TOK, 1536, 256, smem, e1);
  EpiBf16 e2{(u16*)(ws + OFF_BIG + BIG_KVM), LD_KVM, 2048};
  gemm_phase((const u16*)(ws + OFF_BIG + BIG_CKV), 128, (const u16*)(ws + OFF_WT_MLA_UKV), 128, T_TOK, 2048, 128, smem, e2);
}
DI void phase_mla_ropeq(const Params& p) {
  u16* QM = (u16*)(p.ws + OFF_BIG + BIG_QM);
  const size_t n = (size_t)T_TOK * 16 * 16;
  for (size_t i = (size_t)blockIdx.x * NT + TIDX(); i < n; i += (size_t)gridDim.x * NT) {
    const int jj = (int)(i & 15), h = (int)((i >> 4) & 15); const size_t t = i >> 8;
    u16* q = QM + t * LD_QM + h * 96 + 64;
    const float t1 = bf2f(q[jj]), t2 = bf2f(q[16 + jj]);
    const float freq = powf(10000.f, -(float)jj / 16.f);
    const float ang = (float)(t % SEQ) * freq;
    float sn, cs; sincosf(ang, &sn, &cs);
    q[jj] = f2bf(t1 * cs - t2 * sn);
    q[16 + jj] = f2bf(t1 * sn + t2 * cs);
  }
}

DI void phase_attn_swa(const Params& p, int j, char* smem) {
  char* ws = p.ws;
  const u16* QKV = (const u16*)(ws + OFF_BIG);
  u16* AO = (u16*)(ws + OFF_AO);
  const int tid = TIDX(), lane = tid & 63, w = tid >> 6, r = lane & 31, hh = lane >> 5;
  char* Ks = smem; char* Vs = smem + 256 * 144; float* biasd = (float*)(smem + 2 * 256 * 144);
  const int total = 4 * 2 * 64;
  for (int t = blockIdx.x; t < total; t += gridDim.x) {
    const int n = t & 63, kvh = (t >> 6) & 1, b = t >> 7;
    const bool has_prev = n > 0;
    const size_t tok0 = (size_t)b * SEQ + (size_t)n * 128;
    const u16* Kc = QKV + tok0 * 1280 + 1024 + kvh * 64;
    const u16* Vc = QKV + tok0 * 1280 + 1152 + kvh * 64;
#pragma unroll
    for (int i = 0; i < 8; i++) {
      const int c = tid + 256 * i, row = c >> 3, ch = c & 7;
      if (row >= 128 || has_prev) {
        const ptrdiff_t off = (ptrdiff_t)(row - 128) * 1280 + ch * 8;
        *(u32x4*)(Ks + row * 144 + ch * 16) = *(const u32x4*)(Kc + off);
        *(u32x4*)(Vs + row * 144 + ch * 16) = *(const u32x4*)(Vc + off);
      }
    }
#pragma unroll
    for (int i = 0; i < 4; i++) {
      const int e = tid + 256 * i, g = e >> 7, d = e & 127;
      biasd[e] = p.rel_bias[rel_bucket(d) * 16 + kvh * 8 + g] * 1.4426950408889634f;
    }
    __syncthreads();
    const int qi = 32 * w + r;
    for (int g = 0; g < 8; g++) {
      const int h = kvh * 8 + g;
      const float* bd = biasd + g * 128;
      bf16x8 qf[4];
      const u16* qrow = QKV + (tok0 + qi) * 1280 + h * 64;
#pragma unroll
      for (int ks = 0; ks < 4; ks++) qf[ks] = *(const bf16x8*)(qrow + ks * 16 + hh * 8);
      AttnState st; attn_init(st);
      for (int kt = 0; kt < 5; kt++) {
        const int kwin = 32 * (w + kt);
        if (!has_prev && kwin < 128) continue;
        if (kt == 0 || kt == 4) {
          attn_step<4, 144, 144, true>(st, qf, Ks + kwin * 144, Vs + kwin * 144, lane,
            [&](int i, float raw, bool& v) -> float {
              const int dist = 128 + qi - (kwin + crow(i, hh));
              v = (dist >= 0) && (dist <= 127);
              const int dc = dist < 0 ? 0 : (dist > 127 ? 127 : dist);
              return raw * (0.125f * 1.4426950408889634f) + bd[dc];
            });
        } else {
          attn_step<4, 144, 144, false>(st, qf, Ks + kwin * 144, Vs + kwin * 144, lane,
            [&](int i, float raw, bool& v) -> float {
              const int dist = 128 + qi - (kwin + crow(i, hh));
              return raw * (0.125f * 1.4426950408889634f) + bd[dist];
            });
        }
      }
      float inv_l, lse; attn_final(st, inv_l, lse);
      const float sc = inv_l / (1.f + __expf(-(lse - p.swa_sinks[j * 16 + h])));
      attn_store(st, AO + (tok0 + qi) * LDX + h * 64, sc, hh);
    }
    __syncthreads();
  }
}
DI void phase_attn_dil(const Params& p, char* smem) {
  char* ws = p.ws;
  u16* QKV = (u16*)(ws + OFF_BIG);
  float* LSE = (float*)(ws + OFF_LSE);
  const int total = 3 * 4096;
  for (int t = blockIdx.x; t < total; t += gridDim.x) {
    const int g = t >> 12; const int u = t & 4095;
    const int dil = (g == 0) ? 1 : (g == 1 ? 4 : 16);
    const int nb = 64 / dil;
    const int n = u % nb; int v = u / nb;
    const int h = v & 15; v >>= 4;
    const int rr = v % dil, b = v / dil;
    const size_t tok0 = (size_t)b * SEQ + (size_t)(n * 128) * dil + rr;
    const size_t rs = (size_t)dil * LD_DIL;
    u16* Q = QKV + tok0 * LD_DIL + (size_t)(g * 3) * 1024 + h * 64;
    const u16* Kc = QKV + tok0 * LD_DIL + (size_t)(g * 3 + 1) * 1024 + h * 64;
    const u16* Vc = QKV + tok0 * LD_DIL + (size_t)(g * 3 + 2) * 1024 + h * 64;
    band_tile(Q, Kc, Vc, rs, n > 0, dil, 128, p.rel_bias, h, Q, rs, LSE + ((size_t)g * T_TOK + tok0) * 16 + h, (size_t)dil * 16,
              false, 0.f, smem);
  }
}
DI void phase_dil_mix(const Params& p) {
  char* ws = p.ws;
  const u16* QKV = (const u16*)(ws + OFF_BIG);
  const float* LSE = (const float*)(ws + OFF_LSE);
  u16* AO = (u16*)(ws + OFF_AO);
  const size_t n = (size_t)T_TOK * 16 * 8;
  for (size_t i = (size_t)blockIdx.x * NT + TIDX(); i < n; i += (size_t)gridDim.x * NT) {
    const int c = (int)(i & 7), h = (int)((i >> 3) & 15); const size_t t = i >> 7;
    const float l0 = LSE[(0 * (size_t)T_TOK + t) * 16 + h], l1 = LSE[(1 * (size_t)T_TOK + t) * 16 + h], l2 = LSE[(2 * (size_t)T_TOK + t) * 16 + h];
    const float mx = fmaxf(l0, fmaxf(l1, l2));
    float w0 = __expf(l0 - mx), w1 = __expf(l1 - mx), w2 = __expf(l2 - mx);
    const float inv = 1.f / (w0 + w1 + w2); w0 *= inv; w1 *= inv; w2 *= inv;
    const uint4 a = *(const uint4*)(QKV + t * LD_DIL + 0 * 1024 + h * 64 + c * 8);
    const uint4 b = *(const uint4*)(QKV + t * LD_DIL + 3 * 1024 + h * 64 + c * 8);
    const uint4 d = *(const uint4*)(QKV + t * LD_DIL + 6 * 1024 + h * 64 + c * 8);
    uint4 o;
    o.x = pack2(w0 * bflo(a.x) + w1 * bflo(b.x) + w2 * bflo(d.x), w0 * bfhi(a.x) + w1 * bfhi(b.x) + w2 * bfhi(d.x));
    o.y = pack2(w0 * bflo(a.y) + w1 * bflo(b.y) + w2 * bflo(d.y), w0 * bfhi(a.y) + w1 * bfhi(b.y) + w2 * bfhi(d.y));
    o.z = pack2(w0 * bflo(a.z) + w1 * bflo(b.z) + w2 * bflo(d.z), w0 * bfhi(a.z) + w1 * bfhi(b.z) + w2 * bfhi(d.z));
    o.w = pack2(w0 * bflo(a.w) + w1 * bflo(b.w) + w2 * bflo(d.w), w0 * bfhi(a.w) + w1 * bfhi(b.w) + w2 * bfhi(d.w));
    *(uint4*)(AO + t * LDX + h * 64 + c * 8) = o;
  }
}

DI void phase_attn_mla(const Params& p, char* smem) {
  char* ws = p.ws;
  const u16* QM = (const u16*)(ws + OFF_BIG + BIG_QM);
  const u16* KVM = (const u16*)(ws + OFF_BIG + BIG_KVM);
  const u16* KR = (const u16*)(ws + OFF_BIG + BIG_KR);
  u16* AO = (u16*)(ws + OFF_AO);
  const int tid = TIDX(), lane = tid & 63, w = tid >> 6, r = lane & 31, hh = lane >> 5;
  constexpr int KSTR = 208, VSTR = 144;
  char* Ks = smem; char* Vs = smem + 64 * KSTR;
  const int total = 2048; const int G = gridDim.x;
  const float scale = 0.10206207261596575f * 1.4426950408889634f;
  for (int k = 0; k * G < total; k++) {
    const int item = (k & 1) ? (k * G + (G - 1 - (int)blockIdx.x)) : (k * G + (int)blockIdx.x);
    if (item >= total) continue;
    const int n = 31 - (item >> 6); const int bh = item & 63; const int b = bh >> 4, h = bh & 15;
    const size_t tokb = (size_t)b * SEQ;
    const int qmin0 = n * 256 + 64 * w;
    bf16x8* qfa = (bf16x8*)(smem + 64 * KSTR + 64 * VSTR) + ((w * 2 + 0) * 64 + lane) * 6;
    bf16x8* qfb = (bf16x8*)(smem + 64 * KSTR + 64 * VSTR) + ((w * 2 + 1) * 64 + lane) * 6;
    {
      const u16* qrow = QM + (tokb + qmin0 + r) * LD_QM + h * 96;
#pragma unroll
      for (int ks = 0; ks < 4; ks++) { qfa[ks] = *(const bf16x8*)(qrow + ks * 16 + hh * 8); qfb[ks] = *(const bf16x8*)(qrow + 32 * LD_QM + ks * 16 + hh * 8); }
#pragma unroll
      for (int sb = 0; sb < 2; sb++) {
        const u16* qr = qrow + sb * 32 * LD_QM;
        union { bf16x8 v; unsigned u[4]; } t1, t2, o1, o2;
        t1.v = *(const bf16x8*)(qr + 64 + hh * 8); t2.v = *(const bf16x8*)(qr + 80 + hh * 8);
        const float pos = (float)(qmin0 + sb * 32 + r);
#pragma unroll
        for (int jp = 0; jp < 4; jp++) {
          float r1[2], r2[2];
#pragma unroll
          for (int e = 0; e < 2; e++) {
            const int jr = 8 * hh + 2 * jp + e;
            const float a1 = e ? bfhi(t1.u[jp]) : bflo(t1.u[jp]);
            const float a2 = e ? bfhi(t2.u[jp]) : bflo(t2.u[jp]);
            const float freq = powf(10000.f, -(float)jr / 16.f);
            float sn, cs; sincosf(pos * freq, &sn, &cs);
            r1[e] = a1 * cs - a2 * sn; r2[e] = a1 * sn + a2 * cs;
          }
          o1.u[jp] = pack2(r1[0], r1[1]); o2.u[jp] = pack2(r2[0], r2[1]);
        }
        if (sb == 0) { qfa[4] = o1.v; qfa[5] = o2.v; } else { qfb[4] = o1.v; qfb[5] = o2.v; }
      }
    }
    AttnState sta, stb; attn_init(sta); attn_init(stb);
    const int ntiles = 4 * n + 4;
    u32x4 rk[3], rv[2];
    auto gload = [&](int kt) {
      const size_t kb = tokb + (size_t)kt * 64;
#pragma unroll
      for (int i = 0; i < 3; i++) {
        const int c = tid + 256 * i, row = c / 12, ch = c % 12;
        rk[i] = (ch < 8) ? *(const u32x4*)(KVM + (kb + row) * LD_KVM + h * 128 + ch * 8)
                         : *(const u32x4*)(KR + (kb + row) * 32 + (ch - 8) * 8);
      }
#pragma unroll
      for (int i = 0; i < 2; i++) {
        const int c = tid + 256 * i, row = c >> 3, ch = c & 7;
        rv[i] = *(const u32x4*)(KVM + (kb + row) * LD_KVM + h * 128 + 64 + ch * 8);
      }
    };
    gload(0);
    for (int kt = 0; kt < ntiles; kt++) {
#pragma unroll
      for (int i = 0; i < 3; i++) { const int c = tid + 256 * i, row = c / 12, ch = c % 12; *(u32x4*)(Ks + row * KSTR + ch * 16) = rk[i]; }
#pragma unroll
      for (int i = 0; i < 2; i++) { const int c = tid + 256 * i, row = c >> 3, ch = c & 7; *(u32x4*)(Vs + row * VSTR + ch * 16) = rv[i]; }
      __syncthreads();
      if (kt + 1 < ntiles) gload(kt + 1);
#pragma unroll
      for (int sub = 0; sub < 2; sub++) {
        const int kb0 = kt * 64 + sub * 32;
        if (kb0 + 31 <= qmin0) {
          attn_step_raw2<6, KSTR, VSTR>(sta, stb, qfa, qfb, Ks + sub * 32 * KSTR, Vs + sub * 32 * VSTR, lane, scale);
          continue;
        }
        if (kb0 <= qmin0 + 31) {
          if (kb0 + 31 > qmin0) {
            const int qpos = qmin0 + r;
            attn_step<6, KSTR, VSTR, true>(sta, qfa, Ks + sub * 32 * KSTR, Vs + sub * 32 * VSTR, lane,
              [&](int i, float raw, bool& v) -> float { v = (kb0 + crow(i, hh)) <= qpos; return raw * scale; });
          } else {
            attn_step_raw<6, KSTR, VSTR>(sta, qfa, Ks + sub * 32 * KSTR, Vs + sub * 32 * VSTR, lane, scale);
          }
        }
        if (kb0 <= qmin0 + 63) {
          if (kb0 + 31 > qmin0 + 32) {
            const int qpos = qmin0 + 32 + r;
            attn_step<6, KSTR, VSTR, true>(stb, qfb, Ks + sub * 32 * KSTR, Vs + sub * 32 * VSTR, lane,
              [&](int i, float raw, bool& v) -> float { v = (kb0 + crow(i, hh)) <= qpos; return raw * scale; });
          } else {
            attn_step_raw<6, KSTR, VSTR>(stb, qfb, Ks + sub * 32 * KSTR, Vs + sub * 32 * VSTR, lane, scale);
          }
        }
      }
      __syncthreads();
    }
    float inv_l, lse;
    attn_final(sta, inv_l, lse);
    attn_store(sta, AO + (tokb + qmin0 + r) * LDX + h * 64, inv_l, hh);
    attn_final(stb, inv_l, lse);
    attn_store(stb, AO + (tokb + qmin0 + 32 + r) * LDX + h * 64, inv_l, hh);
  }
}

DI void phase_outproj(const Params& p, int L, char* smem) {
  char* ws = p.ws;
  const int kind = L % 3, j = L / 3;
  const u16* W = (kind == 0) ? (const u16*)(ws + OFF_WT_SWA_OUT) + (size_t)j * 1024 * LDW
               : (kind == 1) ? (const u16*)(ws + OFF_WT_DIL_OUT) : (const u16*)(ws + OFF_WT_MLA_OUT);
  EpiBf16 e{(u16*)(ws + OFF_BIG + BIG_Y), LD_Y, 1024};
  gemm_phase((const u16*)(ws + OFF_AO), LDX, W, LDW, T_TOK, 1024, 1024, smem, e);
}

DI void ln_row_store(const float* v, const float* g, const float* bta, int lane, float* outf, u16* outb) {
  float s = 0.f;
#pragma unroll
  for (int i = 0; i < 16; i++) s += v[i];
  const float mu = wave_sum(s) * (1.f / 1024.f);
  float q = 0.f;
#pragma unroll
  for (int i = 0; i < 16; i++) { const float d = v[i] - mu; q += d * d; }
  const float var = wave_sum(q) * (1.f / 1024.f);
  const float rstd = rsqrtf(var + 1e-5f);
#pragma unroll
  for (int half = 0; half < 2; half++) {
    const int c0 = half * 512 + lane * 8;
    const float4 g0 = *(const float4*)(g + c0), g1 = *(const float4*)(g + c0 + 4);
    const float4 b0 = *(const float4*)(bta + c0), b1 = *(const float4*)(bta + c0 + 4);
    float o[8];
    const float gg[8] = {g0.x, g0.y, g0.z, g0.w, g1.x, g1.y, g1.z, g1.w};
    const float bb[8] = {b0.x, b0.y, b0.z, b0.w, b1.x, b1.y, b1.z, b1.w};
#pragma unroll
    for (int i = 0; i < 8; i++) o[i] = (v[half * 8 + i] - mu) * rstd * gg[i] + bb[i];
    if (outf) {
      *(float4*)(outf + c0) = make_float4(o[0], o[1], o[2], o[3]);
      *(float4*)(outf + c0 + 4) = make_float4(o[4], o[5], o[6], o[7]);
    }
    if (outb) {
      uint4 ob; ob.x = pack2(o[0], o[1]); ob.y = pack2(o[2], o[3]); ob.z = pack2(o[4], o[5]); ob.w = pack2(o[6], o[7]);
      *(uint4*)(outb + c0) = ob;
    }
  }
}
DI void load_row16(const float* src, int lane, float* v) {
#pragma unroll
  for (int half = 0; half < 2; half++) {
    const float4 a = *(const float4*)(src + half * 512 + lane * 8), b = *(const float4*)(src + half * 512 + lane * 8 + 4);
    v[half * 8 + 0] = a.x; v[half * 8 + 1] = a.y; v[half * 8 + 2] = a.z; v[half * 8 + 3] = a.w;
    v[half * 8 + 4] = b.x; v[half * 8 + 5] = b.y; v[half * 8 + 6] = b.z; v[half * 8 + 7] = b.w;
  }
}

DI void load_row16_bf(const u16* src, int lane, float* v) {
#pragma unroll
  for (int half = 0; half < 2; half++) {
    const u32x4 a = *(const u32x4*)(src + half * 512 + lane * 8);
#pragma unroll
    for (int k = 0; k < 4; k++) { v[half * 8 + 2 * k] = bflo(a[k]); v[half * 8 + 2 * k + 1] = bfhi(a[k]); }
  }
}

DI void phase_ln1(const Params& p, int L) {
  char* ws = p.ws;
  const u16* Y = (const u16*)(ws + OFF_BIG + BIG_Y);
  u16* XB = (u16*)(ws + OFF_XB);
  const float* g = p.ln_g + (size_t)(L * 2 + 0) * 1024; const float* bt = p.ln_b + (size_t)(L * 2 + 0) * 1024;
  const int lane = TIDX() & 63, wave = TIDX() >> 6;
  for (int t = blockIdx.x * 4 + wave; t < T_TOK; t += gridDim.x * 4) {
    float xv[16], yv[16];
    if (L == 0) load_row16(p.x + (size_t)t * 1024, lane, xv);
    else load_row16_bf(XB + (size_t)t * LDX, lane, xv);
    load_row16_bf(Y + (size_t)t * LD_Y, lane, yv);
#pragma unroll
    for (int i = 0; i < 16; i++) xv[i] = DN_ALPHA * xv[i] + yv[i];
    ln_row_store(xv, g, bt, lane, nullptr, XB + (size_t)t * LDX);
  }
}

DI void phase_peer_q(const Params& p, int L, char* smem) {
  char* ws = p.ws;
  EpiBf16 e{(u16*)(ws + OFF_BIG + BIG_PQ), LD_PQ, 2048};
  gemm_phase((const u16*)(ws + OFF_XB), LDX, (const u16*)(ws + OFF_WT_PEER_Q) + (size_t)L * 2048 * LDW, LDW, T_TOK, 2048, 1024, smem, e);
}

DI unsigned f2ord(float f) { const unsigned u = __float_as_uint(f); return (u & 0x80000000u) ? ~u : (u | 0x80000000u); }
DI float ord2f(unsigned o) { const unsigned u = (o & 0x80000000u) ? (o & 0x7fffffffu) : ~o; return __uint_as_float(u); }
DI void topk_insert(unsigned (&Lst)[16], unsigned x) {
#pragma unroll
  for (int j = 0; j < 16; j++) { const unsigned hi = max(Lst[j], x); x = min(Lst[j], x); Lst[j] = hi; }
}

DI void ce_desc(unsigned& a, unsigned& b) { const unsigned hi = max(a, b), lo = min(a, b); a = hi; b = lo; }
DI void sort16_desc(unsigned (&a)[16]) {
#pragma unroll
  for (int k = 2; k <= 16; k <<= 1)
#pragma unroll
    for (int j = k >> 1; j > 0; j >>= 1)
#pragma unroll
      for (int i = 0; i < 16; i++) {
        const int l = i ^ j;
        if (l > i) { if ((i & k) == 0) ce_desc(a[i], a[l]); else ce_desc(a[l], a[i]); }
      }
}
DI void merge16_desc(unsigned (&Lm)[16], const unsigned (&S)[16]) {
#pragma unroll
  for (int i = 0; i < 16; i++) Lm[i] = max(Lm[i], S[15 - i]);
#pragma unroll
  for (int j = 8; j > 0; j >>= 1)
#pragma unroll
    for (int i = 0; i < 16; i++) if ((i & j) == 0) ce_desc(Lm[i], Lm[i + j]);
}

DI void phase_peer_topk(const Params& p, int L, char* smem) {
  char* ws = p.ws;
  const u16* PQ = (const u16*)(ws + OFF_BIG + BIG_PQ);
  const u16* KEYS = (const u16*)(ws + OFF_KEYS) + (size_t)L * 8 * 2 * 128 * 128;
  int* IDX = (int*)(ws + OFF_BIG + BIG_IDX); float* GATE = (float*)(ws + OFF_BIG + BIG_GATE); float* SUE = (float*)(ws + OFF_BIG + BIG_SUE);
  const float* SU = (const float*)(ws + OFF_SU); const float* SV = (const float*)(ws + OFF_SV);
  const int tid = TIDX(), lane = tid & 63, w = tid >> 6, r = lane & 31, hh = lane >> 5;
  constexpr int SST = 132;
  float* sc = (float*)smem;
  unsigned* fin = (unsigned*)(smem + 2 * 64 * SST * 4);
  const int total = (T_TOK / 64) * 8;
  for (int t = blockIdx.x; t < total; t += gridDim.x) {
    const int h = t & 7, tt = t >> 3; const size_t tok0 = (size_t)tt * 64;
    {
      const int pp = w & 1, tb = w >> 1;
      bf16x8 af[8];
      const u16* qrow = PQ + (tok0 + tb * 32 + r) * LD_PQ + h * 256 + pp * 128;
#pragma unroll
      for (int ks = 0; ks < 8; ks++) af[ks] = *(const bf16x8*)(qrow + ks * 16 + hh * 8);
      const u16* kbase = KEYS + ((size_t)(h * 2 + pp) * 128) * 128;
#pragma unroll
      for (int kb = 0; kb < 4; kb++) {
        f32x16 acc;
#pragma unroll
        for (int i = 0; i < 16; i++) acc[i] = 0.f;
#pragma unroll
        for (int ks = 0; ks < 8; ks++) {
          const bf16x8 bfr = *(const bf16x8*)(kbase + (size_t)(kb * 32 + r) * 128 + ks * 16 + hh * 8);
          acc = MFMA32(af[ks], bfr, acc);
        }
#pragma unroll
        for (int i = 0; i < 16; i++) sc[(pp * 64 + tb * 32 + crow(i, hh)) * SST + kb * 32 + r] = acc[i];
      }
    }
    __syncthreads();
    const int tok = tid >> 2, part = tid & 3, pp = part & 1, rng = part >> 1;
    unsigned Lst[16];
    {
      const float* row = sc + (pp * 64 + tok) * SST + rng * 64;
#pragma unroll
      for (int c = 0; c < 4; c++) {
        unsigned S[16];
#pragma unroll
        for (int i = 0; i < 4; i++) {
          const float4 v = *(const float4*)(row + c * 16 + i * 4);
          const unsigned kidx = rng * 64 + c * 16 + i * 4;
          S[4 * i + 0] = (f2ord(v.x) & ~127u) | (kidx + 0);
          S[4 * i + 1] = (f2ord(v.y) & ~127u) | (kidx + 1);
          S[4 * i + 2] = (f2ord(v.z) & ~127u) | (kidx + 2);
          S[4 * i + 3] = (f2ord(v.w) & ~127u) | (kidx + 3);
        }
        sort16_desc(S);
        if (c == 0) {
#pragma unroll
          for (int j = 0; j < 16; j++) Lst[j] = S[j];
        } else merge16_desc(Lst, S);
      }
    }
    {
      unsigned S[16];
#pragma unroll
      for (int j = 0; j < 16; j++) S[j] = (unsigned)__shfl_xor((int)Lst[j], 2);
      merge16_desc(Lst, S);
    }
    unsigned k1[16], k2[16];
#pragma unroll
    for (int j = 0; j < 16; j++) {
      const unsigned o = (unsigned)__shfl_xor((int)Lst[j], 1);
      k1[j] = pp ? o : Lst[j]; k2[j] = pp ? Lst[j] : o;
    }
    if (part < 2) {
#pragma unroll
      for (int j = 0; j < 16; j++) fin[(tok * 2 + part) * 16 + j] = part ? k2[j] : k1[j];
    }
    unsigned L2[16];
    {
      float v1[16], v2[16];
#pragma unroll
      for (int j = 0; j < 16; j++) { v1[j] = ord2f(k1[j] & ~127u); v2[j] = ord2f(k2[j] & ~127u); }
#define CAND(a, b) ((f2ord(v1[a] + v2[b]) & ~255u) | (unsigned)((a) * 16 + (b)))
#pragma unroll
      for (int a = 0; a < 16; a++) L2[a] = CAND(a, 0);
      unsigned S[16];
#pragma unroll
      for (int a = 0; a < 8; a++) { S[a] = CAND(a, 1); S[8 + a] = 0u; }
      merge16_desc(L2, S);
#pragma unroll
      for (int b = 0; b < 8; b++) { S[b] = CAND(0, 8 + b); S[8 + b] = 0u; }
      merge16_desc(L2, S);
      S[0] = CAND(0, 2); S[1] = CAND(1, 2); S[2] = CAND(2, 2); S[3] = CAND(3, 2); S[4] = CAND(4, 2);
      S[5] = CAND(0, 3); S[6] = CAND(1, 3); S[7] = CAND(2, 3); S[8] = CAND(3, 3);
      S[9] = CAND(0, 4); S[10] = CAND(1, 4); S[11] = CAND(2, 4);
      S[12] = CAND(0, 5); S[13] = CAND(1, 5);
      S[14] = CAND(0, 6); S[15] = CAND(1, 6);
      sort16_desc(S);
      merge16_desc(L2, S);
      S[0] = CAND(0, 7); S[1] = CAND(1, 7);
#pragma unroll
      for (int j = 2; j < 16; j++) S[j] = 0u;
      merge16_desc(L2, S);
#undef CAND
    }
    float z = 0.f;
    const float mxv = ord2f(L2[0] & ~255u);
    float ev[16];
#pragma unroll
    for (int j = 0; j < 16; j++) { ev[j] = __expf(ord2f(L2[j] & ~255u) - mxv); z += ev[j]; }
    const float iz = 1.f / z;
    __syncthreads();
    {
      int id[4]; float gv[4], suv[4];
#pragma unroll
      for (int jj = 0; jj < 4; jj++) {
        const unsigned key = (part == 0) ? L2[jj] : (part == 1) ? L2[4 + jj] : (part == 2) ? L2[8 + jj] : L2[12 + jj];
        const float e = (part == 0) ? ev[jj] : (part == 1) ? ev[4 + jj] : (part == 2) ? ev[8 + jj] : ev[12 + jj];
        const int ab = key & 255, a = ab >> 4, b = ab & 15;
        const int i1 = fin[(tok * 2 + 0) * 16 + a] & 127, i2 = fin[(tok * 2 + 1) * 16 + b] & 127;
        id[jj] = i1 * 128 + i2;
        gv[jj] = e * iz * SV[id[jj]];
        suv[jj] = SU[id[jj]];
      }
      const size_t o = (tok0 + tok) * 128 + h * 16 + part * 4;
      *(int4*)(IDX + o) = make_int4(id[0], id[1], id[2], id[3]);
      *(float4*)(GATE + o) = make_float4(gv[0], gv[1], gv[2], gv[3]);
      *(float4*)(SUE + o) = make_float4(suv[0], suv[1], suv[2], suv[3]);
    }
  }
}

DI float erf_as(float x) {
  const float ax = fabsf(x);
  const float t = __builtin_amdgcn_rcpf(__builtin_fmaf(0.3275911f, ax, 1.0f));
  float poly = __builtin_fmaf(1.061405429f, t, -1.453152027f);
  poly = __builtin_fmaf(poly, t, 1.421413741f);
  poly = __builtin_fmaf(poly, t, -0.284496736f);
  poly = __builtin_fmaf(poly, t, 0.254829592f);
  poly *= t;
  const float e = __builtin_amdgcn_exp2f(-ax * ax * 1.4426950408889634f);
  const float r = __builtin_fmaf(-poly, e, 1.0f);
  return copysignf(r, x);
}
DI void ln_row_store16(const float* v, const float* g, const float* bta, int lane, float* outf, u16* outb) {
  float s = 0.f;
#pragma unroll
  for (int i = 0; i < 16; i++) s += v[i];
  const float mu = wave_sum(s) * (1.f / 1024.f);
  float q = 0.f;
#pragma unroll
  for (int i = 0; i < 16; i++) { const float d = v[i] - mu; q += d * d; }
  const float var = wave_sum(q) * (1.f / 1024.f);
  const float rstd = rsqrtf(var + 1e-5f);
  const int c0 = lane * 16;
  float o[16];
#pragma unroll
  for (int k = 0; k < 4; k++) {
    const float4 gg = *(const float4*)(g + c0 + 4 * k), bb = *(const float4*)(bta + c0 + 4 * k);
    o[4 * k + 0] = (v[4 * k + 0] - mu) * rstd * gg.x + bb.x; o[4 * k + 1] = (v[4 * k + 1] - mu) * rstd * gg.y + bb.y;
    o[4 * k + 2] = (v[4 * k + 2] - mu) * rstd * gg.z + bb.z; o[4 * k + 3] = (v[4 * k + 3] - mu) * rstd * gg.w + bb.w;
  }
  if (outf) {
#pragma unroll
    for (int k = 0; k < 4; k++) *(float4*)(outf + c0 + 4 * k) = make_float4(o[4 * k], o[4 * k + 1], o[4 * k + 2], o[4 * k + 3]);
  }
  if (outb) {
    u32x4 a, b;
    a[0] = pack2(o[0], o[1]); a[1] = pack2(o[2], o[3]); a[2] = pack2(o[4], o[5]); a[3] = pack2(o[6], o[7]);
    b[0] = pack2(o[8], o[9]); b[1] = pack2(o[10], o[11]); b[2] = pack2(o[12], o[13]); b[3] = pack2(o[14], o[15]);
    *(u32x4*)(outb + c0) = a; *(u32x4*)(outb + c0 + 8) = b;
  }
}
DI void phase_peer_gather(const Params& p, int L, bool dry = false) {
  char* ws = p.ws;
  const int* IDX = (const int*)(ws + OFF_BIG + BIG_IDX); const float* GATE = (const float*)(ws + OFF_BIG + BIG_GATE);
  const float* SUE = (const float*)(ws + OFF_BIG + BIG_SUE);
  const unsigned char* U8 = (const unsigned char*)(ws + OFF_UB); const unsigned char* V8 = (const unsigned char*)(ws + OFF_VB);
  u16* XB = (u16*)(ws + OFF_XB);
  const float* g = p.ln_g + (size_t)(L * 2 + 1) * 1024; const float* bt = p.ln_b + (size_t)(L * 2 + 1) * 1024;
  const int lane = TIDX() & 63, wave = TIDX() >> 6;
  const int hh = lane >> 5, b4 = (lane >> 4) & 1, b3 = (lane >> 3) & 1;
  const int esel = lane >> 3;
  for (int t = blockIdx.x * 4 + wave; t < T_TOK; t += gridDim.x * 4) {
    f32x2 xv2[8], yv2[8];
    {
      const u32x4* xp = (const u32x4*)(XB + (size_t)t * LDX + lane * 16);
#pragma unroll
      for (int k = 0; k < 2; k++) { const u32x4 a = xp[k];
#pragma unroll
        for (int q = 0; q < 4; q++) { xv2[4 * k + q][0] = bflo(a[q]); xv2[4 * k + q][1] = bfhi(a[q]); } }
    }
#pragma unroll
    for (int i = 0; i < 8; i++) { yv2[i][0] = 0.f; yv2[i][1] = 0.f; }
    const int idx_lo = IDX[(size_t)t * 128 + lane], idx_hi = IDX[(size_t)t * 128 + 64 + lane];
    for (int bch = 0; bch < 16; bch++) {
      const int isrc = (bch < 8) ? idx_lo : idx_hi;
      u32x2 ur[8], vr[8];
#pragma unroll
      for (int jj = 0; jj < 8; jj++) {
        const int e = __builtin_amdgcn_readlane(isrc, ((bch & 7) * 8 + jj));
        ur[jj] = *(const u32x2*)(U8 + (size_t)e * 512 + lane * 8);
        vr[jj] = *(const u32x2*)(V8 + (size_t)e * 512 + lane * 8);
      }
      const float gt = GATE[(size_t)t * 128 + bch * 8 + esel];
      const float sue = SUE[(size_t)t * 128 + bch * 8 + esel];
      float pd[8];
#pragma unroll
      for (int jj = 0; jj < 8; jj++) {
        f32x2 a2 = {0.f, 0.f};
#pragma unroll
        for (int k = 0; k < 2; k++) {
          a2 = __builtin_elementwise_fma(__builtin_amdgcn_cvt_scalef32_pk_f32_fp4(ur[jj][k], 1.0f, 0), xv2[4 * k + 0], a2);
          a2 = __builtin_elementwise_fma(__builtin_amdgcn_cvt_scalef32_pk_f32_fp4(ur[jj][k], 1.0f, 1), xv2[4 * k + 1], a2);
          a2 = __builtin_elementwise_fma(__builtin_amdgcn_cvt_scalef32_pk_f32_fp4(ur[jj][k], 1.0f, 2), xv2[4 * k + 2], a2);
          a2 = __builtin_elementwise_fma(__builtin_amdgcn_cvt_scalef32_pk_f32_fp4(ur[jj][k], 1.0f, 3), xv2[4 * k + 3], a2);
        }
        pd[jj] = a2[0] + a2[1];
      }
      float q4[4], q2[2], q1;
#pragma unroll
      for (int j = 0; j < 4; j++) { const float send = hh ? pd[j] : pd[j + 4]; const float recv = __shfl_xor(send, 32); q4[j] = (hh ? pd[j + 4] : pd[j]) + recv; }
#pragma unroll
      for (int j = 0; j < 2; j++) { const float send = b4 ? q4[j] : q4[j + 2]; const float recv = __shfl_xor(send, 16); q2[j] = (b4 ? q4[j + 2] : q4[j]) + recv; }
      { const float send = b3 ? q2[0] : q2[1]; const float recv = __shfl_xor(send, 8); q1 = (b3 ? q2[1] : q2[0]) + recv; }
      q1 += __shfl_xor(q1, 4); q1 += __shfl_xor(q1, 2); q1 += __shfl_xor(q1, 1);
      const float hv = q1 * sue;
      const float cf = gt * 0.5f * hv * (1.f + erf_as(hv * 0.70710678118654752f));
#pragma unroll
      for (int jj = 0; jj < 8; jj++) {
        const float c = __int_as_float(__builtin_amdgcn_readlane(__float_as_int(cf), jj * 8));
        const f32x2 c2 = {c, c};
#pragma unroll
        for (int k = 0; k < 2; k++) {
          yv2[4 * k + 0] = __builtin_elementwise_fma(__builtin_amdgcn_cvt_scalef32_pk_f32_fp4(vr[jj][k], 1.0f, 0), c2, yv2[4 * k + 0]);
          yv2[4 * k + 1] = __builtin_elementwise_fma(__builtin_amdgcn_cvt_scalef32_pk_f32_fp4(vr[jj][k], 1.0f, 1), c2, yv2[4 * k + 1]);
          yv2[4 * k + 2] = __builtin_elementwise_fma(__builtin_amdgcn_cvt_scalef32_pk_f32_fp4(vr[jj][k], 1.0f, 2), c2, yv2[4 * k + 2]);
          yv2[4 * k + 3] = __builtin_elementwise_fma(__builtin_amdgcn_cvt_scalef32_pk_f32_fp4(vr[jj][k], 1.0f, 3), c2, yv2[4 * k + 3]);
        }
      }
    }
    float xv[16];
#pragma unroll
    for (int i = 0; i < 8; i++) { xv[2 * i] = DN_ALPHA * xv2[i][0] + yv2[i][0]; xv[2 * i + 1] = DN_ALPHA * xv2[i][1] + yv2[i][1]; }
    if (dry) { if (xv[0] == 1234.5678f) XB[t] = 1; }
    else if (L == 3) ln_row_store16(xv, g, bt, lane, p.out + (size_t)t * 1024, nullptr);
    else ln_row_store16(xv, g, bt, lane, nullptr, XB + (size_t)t * LDX);
  }
}

DI bool phase_applies(int L, int ph) {
  const int kind = L % 3;
  if (ph >= 2 && ph <= 4) return kind == 2;
  if (ph == 6) return kind == 1;
  return true;
}
DI void run_phase(const Params& p, int L, int ph, char* smem) {
  const int kind = L % 3;
  switch (ph) {
    case 0: phase_prep(p, smem); break;
    case 1: phase_inproj(p, L, smem); break;
    case 2: phase_mla_norm(p, smem); break;
    case 3: phase_mla_up(p, smem); break;
    case 4: phase_mla_ropeq(p); break;
    case 5: if (kind == 0) phase_attn_swa(p, L / 3, smem); else if (kind == 1) phase_attn_dil(p, smem); else phase_attn_mla(p, smem); break;
    case 6: phase_dil_mix(p); break;
    case 7: phase_outproj(p, L, smem); break;
    case 8: phase_ln1(p, L); break;
    case 9: phase_peer_q(p, L, smem); break;
    case 10: phase_peer_topk(p, L, smem); break;
    case 11: phase_peer_gather(p, L); break;
  }
}

#if ONE_LAUNCH
#ifndef DUP_LAYERS
#define DUP_LAYERS 15
#endif
#ifndef DUP_MASK
#define DUP_MASK 0
#endif
typedef const __attribute__((address_space(4))) Params* KargPtr;
#if defined(__HIP_DEVICE_COMPILE__)
#define LOAD_PARAMS() KargPtr q_ = kp_; asm volatile("" : "+s"(q_)); Params lp_; __builtin_memcpy(&lp_, (const void*)q_, sizeof(Params))
#else
#define LOAD_PARAMS() const Params lp_ = p
#endif
#define PHASE(L, ph) do { LOAD_PARAMS(); run_phase(lp_, (L), (ph), smem); xcd_barrier2((unsigned*)(lp_.ws + OFF_BAR)); } while (0)
__global__ void __launch_bounds__(NT, 2) mega_kernel(Params p) {
  __shared__ __attribute__((aligned(16))) char smem[SMEM_BYTES];
  cg::grid_group grid = cg::this_grid();
  if (TIDX() == 0) g_xb_words = make_uint4(0u, 0u, 0u, 0u);
  __syncthreads();
#if defined(__HIP_DEVICE_COMPILE__)
  KargPtr kp_ = (KargPtr)__builtin_amdgcn_kernarg_segment_ptr();
#endif
  { LOAD_PARAMS(); (void)xcd_barrier_post((unsigned*)(lp_.ws + OFF_BAR), (volatile LAS unsigned*)&g_xb_words); }
  { LOAD_PARAMS(); run_phase(lp_, 0, 0, smem); }
  grid.sync();
  PHASE(0, 1); PHASE(0, 5); PHASE(0, 7); PHASE(0, 8); PHASE(0, 9); PHASE(0, 10); PHASE(0, 11);
  PHASE(1, 1); PHASE(1, 5); PHASE(1, 6); PHASE(1, 7); PHASE(1, 8); PHASE(1, 9); PHASE(1, 10); PHASE(1, 11);
  PHASE(2, 1); PHASE(2, 2); PHASE(2, 3); PHASE(2, 5); PHASE(2, 7); PHASE(2, 8); PHASE(2, 9); PHASE(2, 10); PHASE(2, 11);
  PHASE(3, 1); PHASE(3, 5); PHASE(3, 7); PHASE(3, 8); PHASE(3, 9); PHASE(3, 10);
  { LOAD_PARAMS(); run_phase(lp_, 3, 11, smem); }
}
#else
__global__ void __launch_bounds__(NT, 2) phase_kernel(Params p, int L, int ph) {
  __shared__ __attribute__((aligned(16))) char smem[SMEM_BYTES];
  run_phase(p, L, ph, smem);
}
#endif

extern "C" void kernel_launch(void* const* d_in, const int* in_sizes, int n_in, void* d_out, int out_size, void* d_ws,
                              size_t ws_size, hipStream_t stream) {
  Params p{};
  p.x = (const float*)d_in[0]; p.rel_bias = (const float*)d_in[1]; p.ln_g = (const float*)d_in[2]; p.ln_b = (const float*)d_in[3];
  p.swa_w_in = (const float*)d_in[4]; p.swa_sinks = (const float*)d_in[5]; p.swa_w_out = (const float*)d_in[6];
  p.dil_w_in = (const float*)d_in[7]; p.dil_w_out = (const float*)d_in[8];
  p.mla_w_in = (const float*)d_in[9]; p.mla_q_norm = (const float*)d_in[10]; p.mla_w_uq = (const float*)d_in[11];
  p.mla_kv_norm = (const float*)d_in[12]; p.mla_w_ukv = (const float*)d_in[13]; p.mla_w_out = (const float*)d_in[14];
  p.peer_w_q = (const float*)d_in[15]; p.peer_keys = (const float*)d_in[16]; p.peer_u = (const float*)d_in[17]; p.peer_v = (const float*)d_in[18];
  p.out = (float*)d_out; p.ws = (char*)d_ws;
  if (ws_size < WS_TOTAL) { fprintf(stderr, "workspace too small: %zu < %zu\n", ws_size, (size_t)WS_NEEDED); return; }
#if ONE_LAUNCH
  static int grid_blocks = 0;
  if (!grid_blocks) {
    int dev = 0, cus = 0, per_cu = 0;
    hipGetDevice(&dev);
    hipDeviceGetAttribute(&cus, hipDeviceAttributeMultiprocessorCount, dev);
    hipOccupancyMaxActiveBlocksPerMultiprocessor(&per_cu, mega_kernel, NT, 0);
    if (per_cu > 2) per_cu = 2;
    if (per_cu < 1) per_cu = 1;
    grid_blocks = cus * per_cu;
  }
  (void)hipMemsetAsync((char*)d_ws + OFF_BAR, 0, XCD_BAR_WORDS * 4, stream);
  void* args[] = {&p};
  hipError_t e = hipLaunchCooperativeKernel((void*)mega_kernel, dim3(grid_blocks), dim3(NT), args, 0, stream);
  if (e != hipSuccess) fprintf(stderr, "cooperative launch failed: %s (grid %d)\n", hipGetErrorString(e), grid_blocks);
#else
  const int grid_blocks = 512;
  phase_kernel<<<grid_blocks, NT, 0, stream>>>(p, 0, 0);
  for (int L = 0; L < 4; L++)
    for (int ph = 1; ph <= 11; ph++) {
      const int kind = L % 3;
      bool ok = true;
      if (ph >= 2 && ph <= 4) ok = (kind == 2);
      if (ph == 6) ok = (kind == 1);
      if (ok) phase_kernel<<<grid_blocks, NT, 0, stream>>>(p, L, ph);
    }
#endif
}
```

```cpp
#include <hip/hip_runtime.h>
#include <hip/hip_cooperative_groups.h>
#include <cstdio>
#include <cstdint>
namespace cg = cooperative_groups;

#ifndef ZERO_ATTN_MASK
#define ZERO_ATTN_MASK 0
#endif
#ifndef ZERO_PEER_MASK
#define ZERO_PEER_MASK 0
#endif
#ifndef ONE_LAUNCH
#define ONE_LAUNCH 1
#endif

typedef unsigned short u16;
typedef __attribute__((ext_vector_type(8))) short bf16x8;
typedef __attribute__((ext_vector_type(4))) short s16x4;
typedef __attribute__((ext_vector_type(16))) float f32x16;
typedef __attribute__((ext_vector_type(4))) unsigned u32x4;
typedef __attribute__((ext_vector_type(2))) float f32x2;
#define DI __device__ __forceinline__
__device__ __forceinline__ int TIDX() { int t = (int)threadIdx.x; asm volatile("" : "+v"(t)); return t; }
#define MFMA32(a, b, c) __builtin_amdgcn_mfma_f32_32x32x16_bf16((a), (b), (c), 0, 0, 0)
#define MFMA16(a, b, c) __builtin_amdgcn_mfma_f32_16x16x32_bf16((a), (b), (c), 0, 0, 0)
typedef __attribute__((ext_vector_type(4))) float f32x4;

constexpr int NT = 256;
constexpr int T_TOK = 32768;
constexpr int SEQ = 8192;
constexpr int DM = 1024;
constexpr float DN_ALPHA = 1.681792830507429f;

constexpr size_t MiB = 1024ull * 1024ull;
constexpr int LDX = 1088;
constexpr int LDW = 1088;
constexpr int LD_SWA = 1280;
constexpr int LD_DIL = 9352;
constexpr int LD_PQ = 2120;
constexpr int LD_Y = 1056;
constexpr int LD_QM = 1608;
constexpr int LD_KVM = 2120;
constexpr size_t OFF_WT_SWA_IN = 0;
constexpr size_t OFF_WT_SWA_OUT = OFF_WT_SWA_IN + 2ull * 1280 * LDW * 2;
constexpr size_t OFF_WT_DIL_IN = OFF_WT_SWA_OUT + 2ull * 1024 * LDW * 2;
constexpr size_t OFF_WT_DIL_OUT = OFF_WT_DIL_IN + 9216ull * LDW * 2;
constexpr size_t OFF_WT_MLA_IN = OFF_WT_DIL_OUT + 1024ull * LDW * 2;
constexpr size_t OFF_WT_MLA_UQ = OFF_WT_MLA_IN + 512ull * LDW * 2;
constexpr size_t OFF_WT_MLA_UKV = OFF_WT_MLA_UQ + 1536ull * 256 * 2;
constexpr size_t OFF_WT_MLA_OUT = OFF_WT_MLA_UKV + 2048ull * 128 * 2;
constexpr size_t OFF_WT_PEER_Q = OFF_WT_MLA_OUT + 1024ull * LDW * 2;
constexpr size_t OFF_KEYS = OFF_WT_PEER_Q + 4ull * 2048 * LDW * 2;
constexpr size_t OFF_WT_END = OFF_KEYS + 4ull * 8 * 2 * 128 * 128 * 2;
constexpr size_t OFF_XF = 56 * MiB;
constexpr size_t OFF_XB = OFF_XF + 128 * MiB;
constexpr size_t OFF_AO = OFF_XB + 68 * MiB;
constexpr size_t OFF_UB = OFF_AO + 68 * MiB;
constexpr size_t OFF_VB = OFF_UB + 32 * MiB;
constexpr size_t OFF_LSE = OFF_VB + 16 * MiB;
constexpr size_t OFF_BIG = OFF_LSE + 6 * MiB;
constexpr size_t WS_NEEDED = OFF_BIG + 585 * MiB;
static_assert(OFF_WT_END <= OFF_XF, "weights overflow");
static_assert((size_t)T_TOK * LD_DIL * 2 <= 585 * MiB, "big overflow");
constexpr size_t BIG_Y = 0;
constexpr size_t BIG_PQ = 192 * MiB;
constexpr size_t BIG_IDX = 384 * MiB;
constexpr size_t BIG_GATE = 416 * MiB;
constexpr size_t BIG_SUE = 448 * MiB;
constexpr size_t OFF_SU = OFF_UB + 16 * MiB;
constexpr size_t OFF_SV = OFF_SU + 65536;
constexpr size_t BIG_CF = 0;
constexpr size_t BIG_CQ = 64 * MiB;
constexpr size_t BIG_CKV = 96 * MiB;
constexpr size_t BIG_KR = 112 * MiB;
constexpr size_t BIG_QM = 128 * MiB;
constexpr size_t BIG_KVM = 256 * MiB;

constexpr size_t OFF_BAR = 960 * MiB;
constexpr size_t WS_TOTAL = OFF_BAR + 65536;
constexpr int SMEM_BYTES = 77824;

struct Params {
  const float* x; const float* rel_bias; const float* ln_g; const float* ln_b;
  const float* swa_w_in; const float* swa_sinks; const float* swa_w_out;
  const float* dil_w_in; const float* dil_w_out;
  const float* mla_w_in; const float* mla_q_norm; const float* mla_w_uq; const float* mla_kv_norm;
  const float* mla_w_ukv; const float* mla_w_out;
  const float* peer_w_q; const float* peer_keys; const float* peer_u; const float* peer_v;
  float* out; char* ws;
};

typedef __bf16 bf16v2 __attribute__((ext_vector_type(2)));
typedef float f32v2 __attribute__((ext_vector_type(2)));
DI unsigned pack2(float a, float b) { f32v2 v = {a, b}; return __builtin_bit_cast(unsigned, __builtin_convertvector(v, bf16v2)); }
DI u16 f2bf(float x) { return (u16)(pack2(x, 0.f) & 0xffffu); }
DI float bf2f(u16 b) { return __uint_as_float(((unsigned)b) << 16); }
DI float bflo(unsigned w) { return __uint_as_float(w << 16); }
DI float bfhi(unsigned w) { return __uint_as_float(w & 0xffff0000u); }
DI int crow(int i, int hh) { return (i & 3) + 8 * (i >> 2) + 4 * hh; }
DI float wave_sum(float v) {
#pragma unroll
  for (int o = 32; o >= 1; o >>= 1) v += __shfl_xor(v, o);
  return v;
}


#define XB_TMO      128
#define XB_XCNT(j)  (256  + 64 * (j))
#define XB_XSUB(j)  (1280 + 64 * (j))
#define XB_XGEN(j)  (2304 + 64 * (j))
#define XB_TOP      3328
#define XB_TOPGEN   3392
#define XCD_BAR_WORDS 3456
#define XB_SPIN_CAP (1u << 18)
#define LAS __attribute__((address_space(3)))
DI unsigned xb_ld(unsigned* p)              { return __hip_atomic_load(p, __ATOMIC_RELAXED, __HIP_MEMORY_SCOPE_AGENT); }
DI unsigned xb_add(unsigned* p, unsigned v) { return __hip_atomic_fetch_add(p, v, __ATOMIC_RELAXED, __HIP_MEMORY_SCOPE_AGENT); }
DI unsigned xb_xcc_id() { return (unsigned)__builtin_amdgcn_s_getreg((3 << 11) | 20) & 0xFu; }
#define XB_SPIN(cond, bar) do { unsigned _sp = 0; while (cond) { __builtin_amdgcn_s_sleep(1); \
    if ((++_sp & 255u) == 0u) { if (xb_ld(&(bar)[XB_TMO])) break; if (_sp > XB_SPIN_CAP) { atomicAdd(&(bar)[XB_TMO], 1u); break; } } } } while (0)
struct XcdBarrier { unsigned* bar; unsigned x; volatile LAS unsigned* st; };
DI XcdBarrier xcd_barrier_post(unsigned* bar, volatile LAS unsigned* st) {
  XcdBarrier b; b.bar = bar; b.x = xb_xcc_id(); b.st = st;
  if (TIDX() == 0) (void)xb_add(&bar[XB_XCNT(b.x)], 1u);
  return b;
}
DI void xcd_barrier_complete(unsigned* bar, unsigned x, unsigned& nloc, unsigned& nx) {
  const unsigned G = gridDim.x * gridDim.y * gridDim.z;
  unsigned sum, cnt, mine, sp = 0u;
  for (;;) {
    sum = 0u; cnt = 0u; mine = 0u;
#pragma unroll
    for (unsigned j = 0; j < 16; ++j) { const unsigned c = xb_ld(&bar[XB_XCNT(j)]); sum += c; cnt += (c > 0u) ? 1u : 0u; mine = (j == x) ? c : mine; }
    if (sum == G) break;
    __builtin_amdgcn_s_sleep(1);
    if ((++sp & 255u) == 0u) { if (xb_ld(&bar[XB_TMO])) break; if (sp > XB_SPIN_CAP) { atomicAdd(&bar[XB_TMO], 1u); break; } }
  }
  nloc = mine > 0u ? mine : 1u; nx = cnt > 0u ? cnt : 1u;
}
__shared__ uint4 g_xb_words;
DI void xcd_barrier(const XcdBarrier& b);
DI void xcd_barrier2(unsigned* bar) {
  XcdBarrier b; b.bar = bar; b.x = xb_xcc_id(); b.st = (volatile LAS unsigned*)&g_xb_words;
  xcd_barrier(b);
}
DI void xcd_barrier(const XcdBarrier& b) {
  asm volatile("s_waitcnt vmcnt(0)" ::: "memory");
  __syncthreads();
  if (TIDX() == 0) {
    unsigned* bar = b.bar;
    __builtin_amdgcn_s_waitcnt(0);
    unsigned nloc = b.st[0], nx = b.st[1];
    if (nloc == 0u) { xcd_barrier_complete(bar, b.x, nloc, nx); b.st[0] = nloc; b.st[1] = nx; }
    const unsigned old = xb_add(&bar[XB_XSUB(b.x)], 1u);
    const unsigned gen = old / nloc;
    if (old + 1u == (gen + 1u) * nloc) {
      __builtin_amdgcn_fence(__ATOMIC_RELEASE, "agent");
      asm volatile("s_waitcnt vmcnt(0)" ::: "memory");
      const unsigned og = xb_add(&bar[XB_TOP], 1u);
      const unsigned tg = og / nx;
      if (og + 1u == (tg + 1u) * nx) xb_add(&bar[XB_TOPGEN], 1u);
      else XB_SPIN(xb_ld(&bar[XB_TOPGEN]) == tg, bar);
      __builtin_amdgcn_fence(__ATOMIC_ACQUIRE, "agent");
      xb_add(&bar[XB_XGEN(b.x)], 1u);
      asm volatile("s_waitcnt vmcnt(0)" ::: "memory");
    } else {
      XB_SPIN(xb_ld(&bar[XB_XGEN(b.x)]) == gen, bar);
      __builtin_amdgcn_fence(__ATOMIC_ACQUIRE, "agent");
      asm volatile("s_waitcnt vmcnt(0)" ::: "memory");
    }
  }
  __syncthreads();
}

DI void transpose_convert(const float* W, u16* Wt, int K, int N, int ldt, char* smem) {
  float (*tile)[33] = (float (*)[33])smem;
  const int tilesN = N / 32, tilesK = K / 64;
  const int tx = TIDX() & 31, ty = TIDX() >> 5;
  for (int t = blockIdx.x; t < tilesK * tilesN; t += gridDim.x) {
    const int tk = t / tilesN, tn = t % tilesN;
#pragma unroll
    for (int i = 0; i < 8; i++) tile[ty + 8 * i][tx] = W[(size_t)(tk * 64 + ty + 8 * i) * N + tn * 32 + tx];
    __syncthreads();
#pragma unroll
    for (int i = 0; i < 4; i++) {
      const int n = ty + 8 * i;
      *(unsigned*)(Wt + (size_t)(tn * 32 + n) * ldt + tk * 64 + 2 * tx) = pack2(tile[2 * tx][n], tile[2 * tx + 1][n]);
    }
    __syncthreads();
  }
}
DI void convert_f32_bf16(const float* src, u16* dst, size_t n) {
  const size_t n8 = n / 8;
  for (size_t i = (size_t)blockIdx.x * NT + TIDX(); i < n8; i += (size_t)gridDim.x * NT) {
    const float4 a = ((const float4*)src)[2 * i], b = ((const float4*)src)[2 * i + 1];
    uint4 o; o.x = pack2(a.x, a.y); o.y = pack2(a.z, a.w); o.z = pack2(b.x, b.y); o.w = pack2(b.z, b.w);
    ((uint4*)dst)[i] = o;
  }
}


DI void convert_rows_bf16(const float* src, u16* dst, int rows, int ldd) {
  const size_t n8 = (size_t)rows * 128;
  for (size_t i = (size_t)blockIdx.x * NT + TIDX(); i < n8; i += (size_t)gridDim.x * NT) {
    const size_t row = i >> 7; const int c = (int)(i & 127);
    const float4 a = ((const float4*)src)[2 * i], b = ((const float4*)src)[2 * i + 1];
    uint4 o; o.x = pack2(a.x, a.y); o.y = pack2(a.z, a.w); o.z = pack2(b.x, b.y); o.w = pack2(b.z, b.w);
    *(uint4*)(dst + row * ldd + c * 8) = o;
  }
}
DI void convert_rows_fp8(const float* src, unsigned char* dst, float* dq, int nrows) {
  const int lane = TIDX() & 63, wave = TIDX() >> 6;
  for (int row = blockIdx.x * 4 + wave; row < nrows; row += gridDim.x * 4) {
    const float4* sp = (const float4*)(src + (size_t)row * 1024 + lane * 16);
    const float4 a = sp[0], b = sp[1], c = sp[2], d = sp[3];
    float m = fmaxf(fmaxf(fmaxf(fabsf(a.x), fabsf(a.y)), fmaxf(fabsf(a.z), fabsf(a.w))), fmaxf(fmaxf(fabsf(b.x), fabsf(b.y)), fmaxf(fabsf(b.z), fabsf(b.w))));
    m = fmaxf(m, fmaxf(fmaxf(fmaxf(fabsf(c.x), fabsf(c.y)), fmaxf(fabsf(c.z), fabsf(c.w))), fmaxf(fmaxf(fabsf(d.x), fabsf(d.y)), fmaxf(fabsf(d.z), fabsf(d.w)))));
#pragma unroll
    for (int o = 32; o >= 1; o >>= 1) m = fmaxf(m, __shfl_xor(m, o));
    const float sc = (m > 0.f) ? 448.f / m : 1.f;
    u32x4 o;
    int w;
    w = 0; w = __builtin_amdgcn_cvt_pk_fp8_f32(a.x * sc, a.y * sc, w, false); w = __builtin_amdgcn_cvt_pk_fp8_f32(a.z * sc, a.w * sc, w, true); o[0] = (unsigned)w;
    w = 0; w = __builtin_amdgcn_cvt_pk_fp8_f32(b.x * sc, b.y * sc, w, false); w = __builtin_amdgcn_cvt_pk_fp8_f32(b.z * sc, b.w * sc, w, true); o[1] = (unsigned)w;
    w = 0; w = __builtin_amdgcn_cvt_pk_fp8_f32(c.x * sc, c.y * sc, w, false); w = __builtin_amdgcn_cvt_pk_fp8_f32(c.z * sc, c.w * sc, w, true); o[2] = (unsigned)w;
    w = 0; w = __builtin_amdgcn_cvt_pk_fp8_f32(d.x * sc, d.y * sc, w, false); w = __builtin_amdgcn_cvt_pk_fp8_f32(d.z * sc, d.w * sc, w, true); o[3] = (unsigned)w;
    *(u32x4*)(dst + (size_t)row * 1024 + lane * 16) = o;
    if (lane == 0) dq[row] = (m > 0.f) ? m * (1.f / 448.f) : 1.f;
  }
}

typedef __attribute__((ext_vector_type(2))) unsigned u32x2;
DI void convert_rows_fp4(const float* src, unsigned char* dst, float* dq, int nrows) {
  const int lane = TIDX() & 63, wave = TIDX() >> 6;
  for (int row = blockIdx.x * 4 + wave; row < nrows; row += gridDim.x * 4) {
    const float4* sp = (const float4*)(src + (size_t)row * 1024 + lane * 16);
    const float4 a = sp[0], b = sp[1], c = sp[2], d = sp[3];
    float m = fmaxf(fmaxf(fmaxf(fabsf(a.x), fabsf(a.y)), fmaxf(fabsf(a.z), fabsf(a.w))), fmaxf(fmaxf(fabsf(b.x), fabsf(b.y)), fmaxf(fabsf(b.z), fabsf(b.w))));
    m = fmaxf(m, fmaxf(fmaxf(fmaxf(fabsf(c.x), fabsf(c.y)), fmaxf(fabsf(c.z), fabsf(c.w))), fmaxf(fmaxf(fabsf(d.x), fabsf(d.y)), fmaxf(fabsf(d.z), fabsf(d.w)))));
#pragma unroll
    for (int o = 32; o >= 1; o >>= 1) m = fmaxf(m, __shfl_xor(m, o));
    const float sc = (m > 0.f) ? 6.f / m : 1.f;
    unsigned w0 = 0, w1 = 0;
    w0 = __builtin_amdgcn_cvt_scalef32_pk_fp4_f32(w0, a.x * sc, a.y * sc, 1.0f, 0);
    w0 = __builtin_amdgcn_cvt_scalef32_pk_fp4_f32(w0, a.z * sc, a.w * sc, 1.0f, 1);
    w0 = __builtin_amdgcn_cvt_scalef32_pk_fp4_f32(w0, b.x * sc, b.y * sc, 1.0f, 2);
    w0 = __builtin_amdgcn_cvt_scalef32_pk_fp4_f32(w0, b.z * sc, b.w * sc, 1.0f, 3);
    w1 = __builtin_amdgcn_cvt_scalef32_pk_fp4_f32(w1, c.x * sc, c.y * sc, 1.0f, 0);
    w1 = __builtin_amdgcn_cvt_scalef32_pk_fp4_f32(w1, c.z * sc, c.w * sc, 1.0f, 1);
    w1 = __builtin_amdgcn_cvt_scalef32_pk_fp4_f32(w1, d.x * sc, d.y * sc, 1.0f, 2);
    w1 = __builtin_amdgcn_cvt_scalef32_pk_fp4_f32(w1, d.z * sc, d.w * sc, 1.0f, 3);
    u32x2 o; o[0] = w0; o[1] = w1;
    *(u32x2*)(dst + (size_t)row * 512 + lane * 8) = o;
    if (lane == 0) dq[row] = (m > 0.f) ? m * (1.f / 6.f) : 1.f;
  }
}

template <class Epi>
DI void gemm_phase(const u16* A, int lda, const u16* Bt, int ldb, int M, int Npad, int K, char* smem, Epi epi) {
  const int tilesN = Npad / 128, tilesM = M / 128;
  const int tid = TIDX(), lane = tid & 63, wave = tid >> 6, r = lane & 31, hh = lane >> 5;
  const int wm = wave >> 1, wn = wave & 1, l15 = lane & 15, lq = lane >> 4;
  char* As = smem; char* Bs = smem + 128 * 144;
  const int nk = K / 64;
  const int xcd = blockIdx.x & 7, local = blockIdx.x >> 3, nloc = gridDim.x >> 3;
  const int ulim = (tilesM >> 3) * tilesN;
  u32x4 ra0[4], rb0[4];
  if (local < ulim) {
    const u16* Ag = A + (size_t)(((local / tilesN) * 8 + xcd) * 128) * lda;
    const u16* Bg = Bt + (size_t)((local % tilesN) * 128) * ldb;
#pragma unroll
    for (int i = 0; i < 4; i++) { const int c = tid + 256 * i, row = c >> 3, kc = c & 7;
      ra0[i] = *(const u32x4*)(Ag + (size_t)row * lda + kc * 8); rb0[i] = *(const u32x4*)(Bg + (size_t)row * ldb + kc * 8); }
  }
  for (int u = local; u < ulim; u += nloc) {
    const int tm = (u / tilesN) * 8 + xcd, tn = u % tilesN;
    const int un = u + nloc;
    const u16* Agn = A + (size_t)((((un < ulim ? un : u) / tilesN) * 8 + xcd) * 128) * lda;
    const u16* Bgn = Bt + (size_t)(((un < ulim ? un : u) % tilesN) * 128) * ldb;
    f32x4 acc[4][4];
#pragma unroll
    for (int a = 0; a < 4; a++)
#pragma unroll
      for (int b = 0; b < 4; b++)
#pragma unroll
        for (int i = 0; i < 4; i++) acc[a][b][i] = 0.f;
    const u16* Ag = A + (size_t)(tm * 128) * lda;
    const u16* Bg = Bt + (size_t)(tn * 128) * ldb;
#define GLOAD(RA, RB, K0) _Pragma("unroll") for (int i = 0; i < 4; i++) { const int c = tid + 256 * i, row = c >> 3, kc = c & 7; \
      RA[i] = *(const u32x4*)(Ag + (size_t)row * lda + (K0) + kc * 8); RB[i] = *(const u32x4*)(Bg + (size_t)row * ldb + (K0) + kc * 8); }
#define LWRITE(RA, RB, BUF) _Pragma("unroll") for (int i = 0; i < 4; i++) { const int c = tid + 256 * i, row = c >> 3, kc = c & 7; \
      *(u32x4*)(As + (BUF) * 36864 + row * 144 + kc * 16) = RA[i]; *(u32x4*)(Bs + (BUF) * 36864 + row * 144 + kc * 16) = RB[i]; }
#define COMPUTE(BUF) _Pragma("unroll") for (int s = 0; s < 2; s++) { bf16x8 af[4], bfr[4]; \
      _Pragma("unroll") for (int mi = 0; mi < 4; mi++) af[mi] = *(const bf16x8*)(As + (BUF) * 36864 + (wm * 64 + mi * 16 + l15) * 144 + (s * 32 + lq * 8) * 2); \
      _Pragma("unroll") for (int ni = 0; ni < 4; ni++) bfr[ni] = *(const bf16x8*)(Bs + (BUF) * 36864 + (wn * 64 + ni * 16 + l15) * 144 + (s * 32 + lq * 8) * 2); \
      _Pragma("unroll") for (int mi = 0; mi < 4; mi++) _Pragma("unroll") for (int ni = 0; ni < 4; ni++) acc[mi][ni] = MFMA16(bfr[ni], af[mi], acc[mi][ni]); }
    LWRITE(ra0, rb0, 0);
    GLOAD(ra0, rb0, 64);
    __syncthreads();
    for (int kt = 0; kt < nk; kt++) {
      const int cb = kt & 1;
      if (kt + 1 < nk) LWRITE(ra0, rb0, (cb ^ 1));
      if (kt + 2 < nk) { GLOAD(ra0, rb0, (kt + 2) * 64); }
      else if (kt + 2 == nk && un < ulim) {
#pragma unroll
        for (int i = 0; i < 4; i++) { const int c = tid + 256 * i, row = c >> 3, kc = c & 7;
          ra0[i] = *(const u32x4*)(Agn + (size_t)row * lda + kc * 8); rb0[i] = *(const u32x4*)(Bgn + (size_t)row * ldb + kc * 8); }
      }
      __builtin_amdgcn_s_setprio(1);
      COMPUTE(cb);
      __builtin_amdgcn_iglp_opt(0);
      __builtin_amdgcn_s_setprio(0);
      __syncthreads();
    }
#undef GLOAD
#undef LWRITE
#undef COMPUTE
    if (Epi::STAGED) {
      char* Cs = smem;
#pragma unroll
      for (int mi = 0; mi < 4; mi++)
#pragma unroll
        for (int ni = 0; ni < 4; ni++) {
          u32x2 o; o[0] = pack2(acc[mi][ni][0], acc[mi][ni][1]); o[1] = pack2(acc[mi][ni][2], acc[mi][ni][3]);
          *(u32x2*)(Cs + (wm * 64 + mi * 16 + l15) * 272 + (wn * 64 + ni * 16 + lq * 4) * 2) = o;
        }
      __syncthreads();
#pragma unroll
      for (int i = 0; i < 8; i++) {
        const int c = tid + 256 * i, row = c >> 4, ch = c & 15;
        const u32x4 v = *(const u32x4*)(Cs + row * 272 + ch * 16);
        epi.store16(tm * 128 + row, tn * 128 + ch * 8, v);
      }
      __syncthreads();
    } else {
#pragma unroll
      for (int mi = 0; mi < 4; mi++)
#pragma unroll
        for (int ni = 0; ni < 4; ni++) {
          const int row = tm * 128 + wm * 64 + mi * 16 + l15;
          const int col = tn * 128 + wn * 64 + ni * 16 + lq * 4;
          epi(row, col, acc[mi][ni][0], acc[mi][ni][1], acc[mi][ni][2], acc[mi][ni][3]);
        }
    }
  }
}
struct EpiBf16 {
  static constexpr bool STAGED = true;
  u16* C; int ldc; int N;
  DI void store16(int row, int col, u32x4 v) const { if (col < N) *(u32x4*)(C + (size_t)row * ldc + col) = v; }
  DI void operator()(int row, int col, float a, float b, float c, float d) const {
    if (col < N) { uint2 o; o.x = pack2(a, b); o.y = pack2(c, d); *(uint2*)(C + (size_t)row * ldc + col) = o; }
  }
};
struct EpiF32 {
  static constexpr bool STAGED = false;
  float* C; int ldc; int N;
  DI void store16(int, int, u32x4) const {}
  DI void operator()(int row, int col, float a, float b, float c, float d) const {
    if (col < N) { float4 o = {a, b, c, d}; *(float4*)(C + (size_t)row * ldc + col) = o; }
  }
};

struct AttnState { f32x16 o[2]; float m, l; };
DI void attn_init(AttnState& st) {
#pragma unroll
  for (int i = 0; i < 16; i++) { st.o[0][i] = 0.f; st.o[1][i] = 0.f; }
  st.m = -1e30f; st.l = 0.f;
}
template <int KS, int KSTR, int VSTR, bool MASKED, class L>
DI void attn_step(AttnState& st, const bf16x8* qf, const char* Kb, const char* Vb, int lane, L logit) {
  const int r = lane & 31, hh = lane >> 5;
  f32x16 s;
#pragma unroll
  for (int i = 0; i < 16; i++) s[i] = 0.f;
#pragma unroll
  for (int ks = 0; ks < KS; ks++) {
    const bf16x8 a = *(const bf16x8*)(Kb + r * KSTR + (ks * 16 + hh * 8) * 2);
    s = MFMA32(a, qf[ks], s);
  }
  float mx = -1e30f;
  bool vld[16];
#pragma unroll
  for (int i = 0; i < 16; i++) {
    bool v = true;
    const float val = logit(i, s[i], v);
    if (MASKED) { vld[i] = v; s[i] = val; if (v) mx = fmaxf(mx, val); }
    else { s[i] = val; mx = fmaxf(mx, val); }
  }
  mx = fmaxf(mx, __shfl_xor(mx, 32));
  const float mnew = fmaxf(st.m, mx);
  const float alpha = __builtin_amdgcn_exp2f(st.m - mnew);
  float ps = 0.f;
#pragma unroll
  for (int i = 0; i < 16; i++) {
    float p = __builtin_amdgcn_exp2f(s[i] - mnew);
    if (MASKED) p = vld[i] ? p : 0.f;
    s[i] = p; ps += p;
  }
  st.l = st.l * alpha + ps;
  st.m = mnew;
  if (__any(alpha != 1.f)) {
#pragma unroll
    for (int i = 0; i < 16; i++) { st.o[0][i] *= alpha; st.o[1][i] *= alpha; }
  }
  bf16x8 pf[2];
#pragma unroll
  for (int s2 = 0; s2 < 2; s2++) {
    union { bf16x8 v; unsigned u[4]; } pk;
#pragma unroll
    for (int j = 0; j < 4; j++) pk.u[j] = pack2(s[8 * s2 + 2 * j], s[8 * s2 + 2 * j + 1]);
    pf[s2] = pk.v;
  }
  const int i16 = lane & 15, q = i16 >> 2, p4 = i16 & 3, rhalf = (lane >> 4) & 1;
#pragma unroll
  for (int s2 = 0; s2 < 2; s2++) {
#pragma unroll
    for (int blk = 0; blk < 2; blk++) {
      const char* a0 = Vb + (16 * s2 + 4 * hh + q) * VSTR + (blk * 32 + rhalf * 16 + 4 * p4) * 2;
      const s16x4 lo = __builtin_amdgcn_ds_read_tr16_b64_v4i16((s16x4 __attribute__((address_space(3)))*)(a0));
      const s16x4 hi = __builtin_amdgcn_ds_read_tr16_b64_v4i16((s16x4 __attribute__((address_space(3)))*)(a0 + 8 * VSTR));
      const bf16x8 vf = __builtin_shufflevector(lo, hi, 0, 1, 2, 3, 4, 5, 6, 7);
      st.o[blk] = MFMA32(vf, pf[s2], st.o[blk]);
    }
  }
}
template <int KS, int KSTR, int VSTR>
DI void attn_step_raw(AttnState& st, const bf16x8* qf, const char* Kb, const char* Vb, int lane, float sc) {
  const int r = lane & 31, hh = lane >> 5;
  f32x16 s;
#pragma unroll
  for (int i = 0; i < 16; i++) s[i] = 0.f;
#pragma unroll
  for (int ks = 0; ks < KS; ks++) {
    const bf16x8 a = *(const bf16x8*)(Kb + r * KSTR + (ks * 16 + hh * 8) * 2);
    s = MFMA32(a, qf[ks], s);
  }
  float mx = s[0];
#pragma unroll
  for (int i = 1; i < 16; i++) mx = fmaxf(mx, s[i]);
  mx = fmaxf(mx, __shfl_xor(mx, 32));
  const float mnew = fmaxf(st.m, mx * sc);
  const float alpha = __builtin_amdgcn_exp2f(st.m - mnew);
  float ps = 0.f;
#pragma unroll
  for (int i = 0; i < 16; i++) { const float p = __builtin_amdgcn_exp2f(__builtin_fmaf(s[i], sc, -mnew)); s[i] = p; ps += p; }
  st.l = st.l * alpha + ps;
  st.m = mnew;
  if (__any(alpha != 1.f)) {
#pragma unroll
    for (int i = 0; i < 16; i++) { st.o[0][i] *= alpha; st.o[1][i] *= alpha; }
  }
  bf16x8 pf[2];
#pragma unroll
  for (int s2 = 0; s2 < 2; s2++) {
    union { bf16x8 v; unsigned u[4]; } pk;
#pragma unroll
    for (int j = 0; j < 4; j++) pk.u[j] = pack2(s[8 * s2 + 2 * j], s[8 * s2 + 2 * j + 1]);
    pf[s2] = pk.v;
  }
  const int i16 = lane & 15, q = i16 >> 2, p4 = i16 & 3, rhalf = (lane >> 4) & 1;
#pragma unroll
  for (int s2 = 0; s2 < 2; s2++) {
#pragma unroll
    for (int blk = 0; blk < 2; blk++) {
      const char* a0 = Vb + (16 * s2 + 4 * hh + q) * VSTR + (blk * 32 + rhalf * 16 + 4 * p4) * 2;
      const s16x4 lo = __builtin_amdgcn_ds_read_tr16_b64_v4i16((s16x4 __attribute__((address_space(3)))*)(a0));
      const s16x4 hi = __builtin_amdgcn_ds_read_tr16_b64_v4i16((s16x4 __attribute__((address_space(3)))*)(a0 + 8 * VSTR));
      const bf16x8 vf = __builtin_shufflevector(lo, hi, 0, 1, 2, 3, 4, 5, 6, 7);
      st.o[blk] = MFMA32(vf, pf[s2], st.o[blk]);
    }
  }
}
template <int KS, int KSTR, int VSTR>
DI void attn_step_raw2(AttnState& sa, AttnState& sb, const bf16x8* qfa, const bf16x8* qfb, const char* Kb, const char* Vb, int lane, float sc) {
  const int r = lane & 31, hh = lane >> 5;
  f32x16 xa, xb;
#pragma unroll
  for (int i = 0; i < 16; i++) { xa[i] = 0.f; xb[i] = 0.f; }
#pragma unroll
  for (int ks = 0; ks < KS; ks++) {
    const bf16x8 a = *(const bf16x8*)(Kb + r * KSTR + (ks * 16 + hh * 8) * 2);
    xa = MFMA32(a, qfa[ks], xa);
    xb = MFMA32(a, qfb[ks], xb);
  }
  float ma = xa[0], mb = xb[0];
#pragma unroll
  for (int i = 1; i < 16; i++) { ma = fmaxf(ma, xa[i]); mb = fmaxf(mb, xb[i]); }
  ma = fmaxf(ma, __shfl_xor(ma, 32)); mb = fmaxf(mb, __shfl_xor(mb, 32));
  const float na = fmaxf(sa.m, ma * sc), nb = fmaxf(sb.m, mb * sc);
  const float aa = __builtin_amdgcn_exp2f(sa.m - na), ab = __builtin_amdgcn_exp2f(sb.m - nb);
  float pa = 0.f, pb = 0.f;
#pragma unroll
  for (int i = 0; i < 16; i++) {
    const float u = __builtin_amdgcn_exp2f(__builtin_fmaf(xa[i], sc, -na)); xa[i] = u; pa += u;
    const float v = __builtin_amdgcn_exp2f(__builtin_fmaf(xb[i], sc, -nb)); xb[i] = v; pb += v;
  }
  sa.l = sa.l * aa + pa; sa.m = na;
  sb.l = sb.l * ab + pb; sb.m = nb;
  if (__any(aa != 1.f)) {
#pragma unroll
    for (int i = 0; i < 16; i++) { sa.o[0][i] *= aa; sa.o[1][i] *= aa; }
  }
  if (__any(ab != 1.f)) {
#pragma unroll
    for (int i = 0; i < 16; i++) { sb.o[0][i] *= ab; sb.o[1][i] *= ab; }
  }
  bf16x8 pfa[2], pfb[2];
#pragma unroll
  for (int s2 = 0; s2 < 2; s2++) {
    union { bf16x8 v; unsigned u[4]; } ka, kb;
#pragma unroll
    for (int j = 0; j < 4; j++) { ka.u[j] = pack2(xa[8 * s2 + 2 * j], xa[8 * s2 + 2 * j + 1]); kb.u[j] = pack2(xb[8 * s2 + 2 * j], xb[8 * s2 + 2 * j + 1]); }
    pfa[s2] = ka.v; pfb[s2] = kb.v;
  }
  const int i16 = lane & 15, q = i16 >> 2, p4 = i16 & 3, rhalf = (lane >> 4) & 1;
#pragma unroll
  for (int s2 = 0; s2 < 2; s2++) {
#pragma unroll
    for (int blk = 0; blk < 2; blk++) {
      const char* a0 = Vb + (16 * s2 + 4 * hh + q) * VSTR + (blk * 32 + rhalf * 16 + 4 * p4) * 2;
      const s16x4 lo = __builtin_amdgcn_ds_read_tr16_b64_v4i16((s16x4 __attribute__((address_space(3)))*)(a0));
      const s16x4 hi = __builtin_amdgcn_ds_read_tr16_b64_v4i16((s16x4 __attribute__((address_space(3)))*)(a0 + 8 * VSTR));
      const bf16x8 vf = __builtin_shufflevector(lo, hi, 0, 1, 2, 3, 4, 5, 6, 7);
      sa.o[blk] = MFMA32(vf, pfa[s2], sa.o[blk]);
      sb.o[blk] = MFMA32(vf, pfb[s2], sb.o[blk]);
    }
  }
}
DI void attn_final(AttnState& st, float& inv_l, float& lse) {
  const float lt = st.l + __shfl_xor(st.l, 32);
  inv_l = 1.f / lt;
  lse = st.m * 0.6931471805599453f + __logf(lt);
}
DI void attn_store(const AttnState& st, u16* dstrow, float sc, int hh) {
#pragma unroll
  for (int blk = 0; blk < 2; blk++)
#pragma unroll
    for (int g = 0; g < 4; g++) {
      uint2 o;
      o.x = pack2(st.o[blk][4 * g] * sc, st.o[blk][4 * g + 1] * sc);
      o.y = pack2(st.o[blk][4 * g + 2] * sc, st.o[blk][4 * g + 3] * sc);
      *(uint2*)(dstrow + blk * 32 + 8 * g + 4 * hh) = o;
    }
}

DI int rel_bucket(int n) {
  if (n < 16) return n;
  const float nf = (float)n;
  int large = 16 + (int)(logf(nf / 16.f) / 4.852030263919617f * 16.f);
  return large < 31 ? large : 31;
}

DI void band_tile(const u16* Q, const u16* Kc, const u16* Vc, size_t rs, bool has_prev, int dil, int max_dist,
                  const float* rel_bias, int head, u16* O, size_t ors, float* lse_out, size_t lse_stride,
                  bool use_sink, float sink, char* smem) {
  const int tid = TIDX(), lane = tid & 63, w = tid >> 6, r = lane & 31, hh = lane >> 5;
  char* Ks = smem; char* Vs = smem + 256 * 144; float* biasd = (float*)(smem + 2 * 256 * 144);
#pragma unroll
  for (int i = 0; i < 8; i++) {
    const int c = tid + 256 * i, row = c >> 3, ch = c & 7;
    if (row >= 128 || has_prev) {
      const ptrdiff_t off = (ptrdiff_t)(row - 128) * (ptrdiff_t)rs + ch * 8;
      *(u32x4*)(Ks + row * 144 + ch * 16) = *(const u32x4*)(Kc + off);
      *(u32x4*)(Vs + row * 144 + ch * 16) = *(const u32x4*)(Vc + off);
    }
  }
  if (tid < 129) biasd[tid] = rel_bias[rel_bucket(tid * dil) * 16 + head] * 1.4426950408889634f;
  bf16x8 qf[4];
  const u16* qrow = Q + (size_t)(32 * w + r) * rs;
#pragma unroll
  for (int ks = 0; ks < 4; ks++) qf[ks] = *(const bf16x8*)(qrow + ks * 16 + hh * 8);
  __syncthreads();
  AttnState st; attn_init(st);
  const int qi = 32 * w + r;
  for (int kt = 0; kt < 5; kt++) {
    const int kwin = 32 * (w + kt);
    if (!has_prev && kwin < 128) continue;
    if (kt == 0 || kt == 4) {
      attn_step<4, 144, 144, true>(st, qf, Ks + kwin * 144, Vs + kwin * 144, lane,
        [&](int i, float raw, bool& v) -> float {
          const int kj = kwin + crow(i, hh);
          const int dist = 128 + qi - kj;
          v = (dist >= 0) && (dist <= max_dist);
          const int dc = dist < 0 ? 0 : (dist > 128 ? 128 : dist);
          return raw * (0.125f * 1.4426950408889634f) + biasd[dc];
        });
    } else {
      attn_step<4, 144, 144, false>(st, qf, Ks + kwin * 144, Vs + kwin * 144, lane,
        [&](int i, float raw, bool& v) -> float {
          const int dist = 128 + qi - (kwin + crow(i, hh));
          return raw * (0.125f * 1.4426950408889634f) + biasd[dist];
        });
    }
  }
  float inv_l, lse; attn_final(st, inv_l, lse);
  float sc = inv_l;
  if (use_sink) sc *= 1.f / (1.f + __expf(-(lse - sink)));
  attn_store(st, O + (size_t)qi * ors, sc, hh);
  if (lse_out && hh == 0) lse_out[(size_t)qi * lse_stride] = lse;
  __syncthreads();
}

DI void phase_prep(const Params& p, char* smem) {
  char* ws = p.ws;
  for (int j = 0; j < 2; j++) {
    transpose_convert(p.swa_w_in + (size_t)j * 1024 * 1280, (u16*)(ws + OFF_WT_SWA_IN) + (size_t)j * 1280 * LDW, 1024, 1280, LDW, smem);
    transpose_convert(p.swa_w_out + (size_t)j * 1024 * 1024, (u16*)(ws + OFF_WT_SWA_OUT) + (size_t)j * 1024 * LDW, 1024, 1024, LDW, smem);
  }
  transpose_convert(p.dil_w_in, (u16*)(ws + OFF_WT_DIL_IN), 1024, 9216, LDW, smem);
  transpose_convert(p.dil_w_out, (u16*)(ws + OFF_WT_DIL_OUT), 1024, 1024, LDW, smem);
  transpose_convert(p.mla_w_in, (u16*)(ws + OFF_WT_MLA_IN), 1024, 416, LDW, smem);
  transpose_convert(p.mla_w_uq, (u16*)(ws + OFF_WT_MLA_UQ), 256, 1536, 256, smem);
  transpose_convert(p.mla_w_ukv, (u16*)(ws + OFF_WT_MLA_UKV), 128, 2048, 128, smem);
  transpose_convert(p.mla_w_out, (u16*)(ws + OFF_WT_MLA_OUT), 1024, 1024, LDW, smem);
  for (int j = 0; j < 4; j++)
    transpose_convert(p.peer_w_q + (size_t)j * 1024 * 2048, (u16*)(ws + OFF_WT_PEER_Q) + (size_t)j * 2048 * LDW, 1024, 2048, LDW, smem);
  {
    uint4* z = (uint4*)((u16*)(ws + OFF_WT_MLA_IN) + 416ull * LDW);
    const size_t n = 96ull * LDW * 2 / 16;
    for (size_t i = (size_t)blockIdx.x * NT + TIDX(); i < n; i += (size_t)gridDim.x * NT) z[i] = make_uint4(0, 0, 0, 0);
  }
  convert_f32_bf16(p.peer_keys, (u16*)(ws + OFF_KEYS), 4ull * 8 * 2 * 128 * 128);
  convert_rows_bf16(p.x, (u16*)(ws + OFF_XB), T_TOK, LDX);
}

DI void phase_inproj(const Params& p, int L, char* smem) {
  char* ws = p.ws;
  const int kind = L % 3, j = L / 3;
  const u16* XB = (const u16*)(ws + OFF_XB);
  if (kind == 0) {
    EpiBf16 e{(u16*)(ws + OFF_BIG), LD_SWA, 1280};
    gemm_phase(XB, LDX, (const u16*)(ws + OFF_WT_SWA_IN) + (size_t)j * 1280 * LDW, LDW, T_TOK, 1280, 1024, smem, e);
  } else if (kind == 1) {
    EpiBf16 e{(u16*)(ws + OFF_BIG), LD_DIL, 9216};
    gemm_phase(XB, LDX, (const u16*)(ws + OFF_WT_DIL_IN), LDW, T_TOK, 9216, 1024, smem, e);
  } else {
    EpiF32 e{(float*)(ws + OFF_BIG + BIG_CF), 416, 416};
    gemm_phase(XB, LDX, (const u16*)(ws + OFF_WT_MLA_IN), LDW, T_TOK, 512, 1024, smem, e);
  }
  convert_rows_fp4(p.peer_u + (size_t)L * 16384 * 1024, (unsigned char*)(ws + OFF_UB), (float*)(ws + OFF_SU), 16384);
  convert_rows_fp4(p.peer_v + (size_t)L * 16384 * 1024, (unsigned char*)(ws + OFF_VB), (float*)(ws + OFF_SV), 16384);
}

DI void phase_mla_norm(const Params& p, char* smem) {
  char* ws = p.ws;
  const float* CF = (const float*)(ws + OFF_BIG + BIG_CF);
  u16* CQ = (u16*)(ws + OFF_BIG + BIG_CQ); u16* CKV = (u16*)(ws + OFF_BIG + BIG_CKV); u16* KR = (u16*)(ws + OFF_BIG + BIG_KR);
  const int lane = TIDX() & 63, wave = TIDX() >> 6;
  for (int t = blockIdx.x * 4 + wave; t < T_TOK; t += gridDim.x * 4) {
    const float* c = CF + (size_t)t * 416;
    const float4 cq = *(const float4*)(c + lane * 4);
    const float2 ckv = *(const float2*)(c + 256 + lane * 2);
    float sq = cq.x * cq.x + cq.y * cq.y + cq.z * cq.z + cq.w * cq.w;
    float skv = ckv.x * ckv.x + ckv.y * ckv.y;
    sq = wave_sum(sq); skv = wave_sum(skv);
    const float rq = rsqrtf(sq * (1.f / 256.f) + 1e-6f), rkv = rsqrtf(skv * (1.f / 128.f) + 1e-6f);
    const float4 gq = *(const float4*)(p.mla_q_norm + lane * 4);
    const float2 gkv = *(const float2*)(p.mla_kv_norm + lane * 2);
    uint2 oq; oq.x = pack2(cq.x * rq * gq.x, cq.y * rq * gq.y); oq.y = pack2(cq.z * rq * gq.z, cq.w * rq * gq.w);
    *(uint2*)(CQ + (size_t)t * 256 + lane * 4) = oq;
    *(unsigned*)(CKV + (size_t)t * 128 + lane * 2) = pack2(ckv.x * rkv * gkv.x, ckv.y * rkv * gkv.y);
    if (lane < 16) {
      const float t1 = c[384 + lane], t2 = c[384 + 16 + lane];
      const float freq = powf(10000.f, -(float)lane / 16.f);
      const float ang = (float)(t % SEQ) * freq;
      float sn, cs; sincosf(ang, &sn, &cs);
      KR[(size_t)t * 32 + lane] = f2bf(t1 * cs - t2 * sn);
      KR[(size_t)t * 32 + 16 + lane] = f2bf(t1 * sn + t2 * cs);
    }
  }
}
DI void phase_mla_up(const Params& p, char* smem) {
  char* ws = p.ws;
  EpiBf16 e1{(u16*)(ws + OFF_BIG + BIG_QM), LD_QM, 1536};
  gemm_phase((const u16*)(ws + OFF_BIG + BIG_CQ), 256, (const u16*)(ws + OFF_WT_MLA_UQ), 256, T_TOK, 1536, 256, smem, e1);
  EpiBf16 e2{(u16*)(ws + OFF_BIG + BIG_KVM), LD_KVM, 2048};
  gemm_phase((const u16*)(ws + OFF_BIG + BIG_CKV), 128, (const u16*)(ws + OFF_WT_MLA_UKV), 128, T_TOK, 2048, 128, smem, e2);
}
DI void phase_mla_ropeq(const Params& p) {
  u16* QM = (u16*)(p.ws + OFF_BIG + BIG_QM);
  const size_t n = (size_t)T_TOK * 16 * 16;
  for (size_t i = (size_t)blockIdx.x * NT + TIDX(); i < n; i += (size_t)gridDim.x * NT) {
    const int jj = (int)(i & 15), h = (int)((i >> 4) & 15); const size_t t = i >> 8;
    u16* q = QM + t * LD_QM + h * 96 + 64;
    const float t1 = bf2f(q[jj]), t2 = bf2f(q[16 + jj]);
    const float freq = powf(10000.f, -(float)jj / 16.f);
    const float ang = (float)(t % SEQ) * freq;
    float sn, cs; sincosf(ang, &sn, &cs);
    q[jj] = f2bf(t1 * cs - t2 * sn);
    q[16 + jj] = f2bf(t1 * sn + t2 * cs);
  }
}

DI void phase_attn_swa(const Params& p, int j, char* smem) {
  char* ws = p.ws;
  const u16* QKV = (const u16*)(ws + OFF_BIG);
  u16* AO = (u16*)(ws + OFF_AO);
  const int tid = TIDX(), lane = tid & 63, w = tid >> 6, r = lane & 31, hh = lane >> 5;
  char* Ks = smem; char* Vs = smem + 256 * 144; float* biasd = (float*)(smem + 2 * 256 * 144);
  const int total = 4 * 2 * 64;
  for (int t = blockIdx.x; t < total; t += gridDim.x) {
    const int n = t & 63, kvh = (t >> 6) & 1, b = t >> 7;
    const bool has_prev = n > 0;
    const size_t tok0 = (size_t)b * SEQ + (size_t)n * 128;
    const u16* Kc = QKV + tok0 * 1280 + 1024 + kvh * 64;
    const u16* Vc = QKV + tok0 * 1280 + 1152 + kvh * 64;
#pragma unroll
    for (int i = 0; i < 8; i++) {
      const int c = tid + 256 * i, row = c >> 3, ch = c & 7;
      if (row >= 128 || has_prev) {
        const ptrdiff_t off = (ptrdiff_t)(row - 128) * 1280 + ch * 8;
        *(u32x4*)(Ks + row * 144 + ch * 16) = *(const u32x4*)(Kc + off);
        *(u32x4*)(Vs + row * 144 + ch * 16) = *(const u32x4*)(Vc + off);
      }
    }
#pragma unroll
    for (int i = 0; i < 4; i++) {
      const int e = tid + 256 * i, g = e >> 7, d = e & 127;
      biasd[e] = p.rel_bias[rel_bucket(d) * 16 + kvh * 8 + g] * 1.4426950408889634f;
    }
    __syncthreads();
    const int qi = 32 * w + r;
    for (int g = 0; g < 8; g++) {
      const int h = kvh * 8 + g;
      const float* bd = biasd + g * 128;
      bf16x8 qf[4];
      const u16* qrow = QKV + (tok0 + qi) * 1280 + h * 64;
#pragma unroll
      for (int ks = 0; ks < 4; ks++) qf[ks] = *(const bf16x8*)(qrow + ks * 16 + hh * 8);
      AttnState st; attn_init(st);
      for (int kt = 0; kt < 5; kt++) {
        const int kwin = 32 * (w + kt);
        if (!has_prev && kwin < 128) continue;
        if (kt == 0 || kt == 4) {
          attn_step<4, 144, 144, true>(st, qf, Ks + kwin * 144, Vs + kwin * 144, lane,
            [&](int i, float raw, bool& v) -> float {
              const int dist = 128 + qi - (kwin + crow(i, hh));
              v = (dist >= 0) && (dist <= 127);
              const int dc = dist < 0 ? 0 : (dist > 127 ? 127 : dist);
              return raw * (0.125f * 1.4426950408889634f) + bd[dc];
            });
        } else {
          attn_step<4, 144, 144, false>(st, qf, Ks + kwin * 144, Vs + kwin * 144, lane,
            [&](int i, float raw, bool& v) -> float {
              const int dist = 128 + qi - (kwin + crow(i, hh));
              return raw * (0.125f * 1.4426950408889634f) + bd[dist];
            });
        }
      }
      float inv_l, lse; attn_final(st, inv_l, lse);
      const float sc = inv_l / (1.f + __expf(-(lse - p.swa_sinks[j * 16 + h])));
      attn_store(st, AO + (tok0 + qi) * LDX + h * 64, sc, hh);
    }
    __syncthreads();
  }
}
DI void phase_attn_dil(const Params& p, char* smem) {
  char* ws = p.ws;
  u16* QKV = (u16*)(ws + OFF_BIG);
  float* LSE = (float*)(ws + OFF_LSE);
  const int total = 3 * 4096;
  for (int t = blockIdx.x; t < total; t += gridDim.x) {
    const int g = t >> 12; const int u = t & 4095;
    const int dil = (g == 0) ? 1 : (g == 1 ? 4 : 16);
    const int nb = 64 / dil;
    const int n = u % nb; int v = u / nb;
    const int h = v & 15; v >>= 4;
    const int rr = v % dil, b = v / dil;
    const size_t tok0 = (size_t)b * SEQ + (size_t)(n * 128) * dil + rr;
    const size_t rs = (size_t)dil * LD_DIL;
    u16* Q = QKV + tok0 * LD_DIL + (size_t)(g * 3) * 1024 + h * 64;
    const u16* Kc = QKV + tok0 * LD_DIL + (size_t)(g * 3 + 1) * 1024 + h * 64;
    const u16* Vc = QKV + tok0 * LD_DIL + (size_t)(g * 3 + 2) * 1024 + h * 64;
    band_tile(Q, Kc, Vc, rs, n > 0, dil, 128, p.rel_bias, h, Q, rs, LSE + ((size_t)g * T_TOK + tok0) * 16 + h, (size_t)dil * 16,
              false, 0.f, smem);
  }
}
DI void phase_dil_mix(const Params& p) {
  char* ws = p.ws;
  const u16* QKV = (const u16*)(ws + OFF_BIG);
  const float* LSE = (const float*)(ws + OFF_LSE);
  u16* AO = (u16*)(ws + OFF_AO);
  const size_t n = (size_t)T_TOK * 16 * 8;
  for (size_t i = (size_t)blockIdx.x * NT + TIDX(); i < n; i += (size_t)gridDim.x * NT) {
    const int c = (int)(i & 7), h = (int)((i >> 3) & 15); const size_t t = i >> 7;
    const float l0 = LSE[(0 * (size_t)T_TOK + t) * 16 + h], l1 = LSE[(1 * (size_t)T_TOK + t) * 16 + h], l2 = LSE[(2 * (size_t)T_TOK + t) * 16 + h];
    const float mx = fmaxf(l0, fmaxf(l1, l2));
    float w0 = __expf(l0 - mx), w1 = __expf(l1 - mx), w2 = __expf(l2 - mx);
    const float inv = 1.f / (w0 + w1 + w2); w0 *= inv; w1 *= inv; w2 *= inv;
    const uint4 a = *(const uint4*)(QKV + t * LD_DIL + 0 * 1024 + h * 64 + c * 8);
    const uint4 b = *(const uint4*)(QKV + t * LD_DIL + 3 * 1024 + h * 64 + c * 8);
    const uint4 d = *(const uint4*)(QKV + t * LD_DIL + 6 * 1024 + h * 64 + c * 8);
    uint4 o;
    o.x = pack2(w0 * bflo(a.x) + w1 * bflo(b.x) + w2 * bflo(d.x), w0 * bfhi(a.x) + w1 * bfhi(b.x) + w2 * bfhi(d.x));
    o.y = pack2(w0 * bflo(a.y) + w1 * bflo(b.y) + w2 * bflo(d.y), w0 * bfhi(a.y) + w1 * bfhi(b.y) + w2 * bfhi(d.y));
    o.z = pack2(w0 * bflo(a.z) + w1 * bflo(b.z) + w2 * bflo(d.z), w0 * bfhi(a.z) + w1 * bfhi(b.z) + w2 * bfhi(d.z));
    o.w = pack2(w0 * bflo(a.w) + w1 * bflo(b.w) + w2 * bflo(d.w), w0 * bfhi(a.w) + w1 * bfhi(b.w) + w2 * bfhi(d.w));
    *(uint4*)(AO + t * LDX + h * 64 + c * 8) = o;
  }
}

DI void phase_attn_mla(const Params& p, char* smem) {
  char* ws = p.ws;
  const u16* QM = (const u16*)(ws + OFF_BIG + BIG_QM);
  const u16* KVM = (const u16*)(ws + OFF_BIG + BIG_KVM);
  const u16* KR = (const u16*)(ws + OFF_BIG + BIG_KR);
  u16* AO = (u16*)(ws + OFF_AO);
  const int tid = TIDX(), lane = tid & 63, w = tid >> 6, r = lane & 31, hh = lane >> 5;
  constexpr int KSTR = 208, VSTR = 144;
  char* Ks = smem; char* Vs = smem + 64 * KSTR;
  const int total = 2048; const int G = gridDim.x;
  const float scale = 0.10206207261596575f * 1.4426950408889634f;
  for (int k = 0; k * G < total; k++) {
    const int item = (k & 1) ? (k * G + (G - 1 - (int)blockIdx.x)) : (k * G + (int)blockIdx.x);
    if (item >= total) continue;
    const int n = 31 - (item >> 6); const int bh = item & 63; const int b = bh >> 4, h = bh & 15;
    const size_t tokb = (size_t)b * SEQ;
    const int qmin0 = n * 256 + 64 * w;
    bf16x8* qfa = (bf16x8*)(smem + 64 * KSTR + 64 * VSTR) + ((w * 2 + 0) * 64 + lane) * 6;
    bf16x8* qfb = (bf16x8*)(smem + 64 * KSTR + 64 * VSTR) + ((w * 2 + 1) * 64 + lane) * 6;
    {
      const u16* qrow = QM + (tokb + qmin0 + r) * LD_QM + h * 96;
#pragma unroll
      for (int ks = 0; ks < 4; ks++) { qfa[ks] = *(const bf16x8*)(qrow + ks * 16 + hh * 8); qfb[ks] = *(const bf16x8*)(qrow + 32 * LD_QM + ks * 16 + hh * 8); }
#pragma unroll
      for (int sb = 0; sb < 2; sb++) {
        const u16* qr = qrow + sb * 32 * LD_QM;
        union { bf16x8 v; unsigned u[4]; } t1, t2, o1, o2;
        t1.v = *(const bf16x8*)(qr + 64 + hh * 8); t2.v = *(const bf16x8*)(qr + 80 + hh * 8);
        const float pos = (float)(qmin0 + sb * 32 + r);
#pragma unroll
        for (int jp = 0; jp < 4; jp++) {
          float r1[2], r2[2];
#pragma unroll
          for (int e = 0; e < 2; e++) {
            const int jr = 8 * hh + 2 * jp + e;
            const float a1 = e ? bfhi(t1.u[jp]) : bflo(t1.u[jp]);
            const float a2 = e ? bfhi(t2.u[jp]) : bflo(t2.u[jp]);
            const float freq = powf(10000.f, -(float)jr / 16.f);
            float sn, cs; sincosf(pos * freq, &sn, &cs);
            r1[e] = a1 * cs - a2 * sn; r2[e] = a1 * sn + a2 * cs;
          }
          o1.u[jp] = pack2(r1[0], r1[1]); o2.u[jp] = pack2(r2[0], r2[1]);
        }
        if (sb == 0) { qfa[4] = o1.v; qfa[5] = o2.v; } else { qfb[4] = o1.v; qfb[5] = o2.v; }
      }
    }
    AttnState sta, stb; attn_init(sta); attn_init(stb);
    const int ntiles = 4 * n + 4;
    u32x4 rk[3], rv[2];
    auto gload = [&](int kt) {
      const size_t kb = tokb + (size_t)kt * 64;
#pragma unroll
      for (int i = 0; i < 3; i++) {
        const int c = tid + 256 * i, row = c / 12, ch = c % 12;
        rk[i] = (ch < 8) ? *(const u32x4*)(KVM + (kb + row) * LD_KVM + h * 128 + ch * 8)
                         : *(const u32x4*)(KR + (kb + row) * 32 + (ch - 8) * 8);
      }
#pragma unroll
      for (int i = 0; i < 2; i++) {
        const int c = tid + 256 * i, row = c >> 3, ch = c & 7;
        rv[i] = *(const u32x4*)(KVM + (kb + row) * LD_KVM + h * 128 + 64 + ch * 8);
      }
    };
    gload(0);
    for (int kt = 0; kt < ntiles; kt++) {
#pragma unroll
      for (int i = 0; i < 3; i++) { const int c = tid + 256 * i, row = c / 12, ch = c % 12; *(u32x4*)(Ks + row * KSTR + ch * 16) = rk[i]; }
#pragma unroll
      for (int i = 0; i < 2; i++) { const int c = tid + 256 * i, row = c >> 3, ch = c & 7; *(u32x4*)(Vs + row * VSTR + ch * 16) = rv[i]; }
      __syncthreads();
      if (kt + 1 < ntiles) gload(kt + 1);
#pragma unroll
      for (int sub = 0; sub < 2; sub++) {
        const int kb0 = kt * 64 + sub * 32;
        if (kb0 + 31 <= qmin0) {
          attn_step_raw2<6, KSTR, VSTR>(sta, stb, qfa, qfb, Ks + sub * 32 * KSTR, Vs + sub * 32 * VSTR, lane, scale);
          continue;
        }
        if (kb0 <= qmin0 + 31) {
          if (kb0 + 31 > qmin0) {
            const int qpos = qmin0 + r;
            attn_step<6, KSTR, VSTR, true>(sta, qfa, Ks + sub * 32 * KSTR, Vs + sub * 32 * VSTR, lane,
              [&](int i, float raw, bool& v) -> float { v = (kb0 + crow(i, hh)) <= qpos; return raw * scale; });
          } else {
            attn_step_raw<6, KSTR, VSTR>(sta, qfa, Ks + sub * 32 * KSTR, Vs + sub * 32 * VSTR, lane, scale);
          }
        }
        if (kb0 <= qmin0 + 63) {
          if (kb0 + 31 > qmin0 + 32) {
            const int qpos = qmin0 + 32 + r;
            attn_step<6, KSTR, VSTR, true>(stb, qfb, Ks + sub * 32 * KSTR, Vs + sub * 32 * VSTR, lane,
              [&](int i, float raw, bool& v) -> float { v = (kb0 + crow(i, hh)) <= qpos; return raw * scale; });
          } else {
            attn_step_raw<6, KSTR, VSTR>(stb, qfb, Ks + sub * 32 * KSTR, Vs + sub * 32 * VSTR, lane, scale);
          }
        }
      }
      __syncthreads();
    }
    float inv_l, lse;
    attn_final(sta, inv_l, lse);
    attn_store(sta, AO + (tokb + qmin0 + r) * LDX + h * 64, inv_l, hh);
    attn_final(stb, inv_l, lse);
    attn_store(stb, AO + (tokb + qmin0 + 32 + r) * LDX + h * 64, inv_l, hh);
  }
}

DI void phase_outproj(const Params& p, int L, char* smem) {
  char* ws = p.ws;
  const int kind = L % 3, j = L / 3;
  const u16* W = (kind == 0) ? (const u16*)(ws + OFF_WT_SWA_OUT) + (size_t)j * 1024 * LDW
               : (kind == 1) ? (const u16*)(ws + OFF_WT_DIL_OUT) : (const u16*)(ws + OFF_WT_MLA_OUT);
  EpiBf16 e{(u16*)(ws + OFF_BIG + BIG_Y), LD_Y, 1024};
  gemm_phase((const u16*)(ws + OFF_AO), LDX, W, LDW, T_TOK, 1024, 1024, smem, e);
}

DI void ln_row_store(const float* v, const float* g, const float* bta, int lane, float* outf, u16* outb) {
  float s = 0.f;
#pragma unroll
  for (int i = 0; i < 16; i++) s += v[i];
  const float mu = wave_sum(s) * (1.f / 1024.f);
  float q = 0.f;
#pragma unroll
  for (int i = 0; i < 16; i++) { const float d = v[i] - mu; q += d * d; }
  const float var = wave_sum(q) * (1.f / 1024.f);
  const float rstd = rsqrtf(var + 1e-5f);
#pragma unroll
  for (int half = 0; half < 2; half++) {
    const int c0 = half * 512 + lane * 8;
    const float4 g0 = *(const float4*)(g + c0), g1 = *(const float4*)(g + c0 + 4);
    const float4 b0 = *(const float4*)(bta + c0), b1 = *(const float4*)(bta + c0 + 4);
    float o[8];
    const float gg[8] = {g0.x, g0.y, g0.z, g0.w, g1.x, g1.y, g1.z, g1.w};
    const float bb[8] = {b0.x, b0.y, b0.z, b0.w, b1.x, b1.y, b1.z, b1.w};
#pragma unroll
    for (int i = 0; i < 8; i++) o[i] = (v[half * 8 + i] - mu) * rstd * gg[i] + bb[i];
    if (outf) {
      *(float4*)(outf + c0) = make_float4(o[0], o[1], o[2], o[3]);
      *(float4*)(outf + c0 + 4) = make_float4(o[4], o[5], o[6], o[7]);
    }
    if (outb) {
      uint4 ob; ob.x = pack2(o[0], o[1]); ob.y = pack2(o[2], o[3]); ob.z = pack2(o[4], o[5]); ob.w = pack2(o[6], o[7]);
      *(uint4*)(outb + c0) = ob;
    }
  }
}
DI void load_row16(const float* src, int lane, float* v) {
#pragma unroll
  for (int half = 0; half < 2; half++) {
    const float4 a = *(const float4*)(src + half * 512 + lane * 8), b = *(const float4*)(src + half * 512 + lane * 8 + 4);
    v[half * 8 + 0] = a.x; v[half * 8 + 1] = a.y; v[half * 8 + 2] = a.z; v[half * 8 + 3] = a.w;
    v[half * 8 + 4] = b.x; v[half * 8 + 5] = b.y; v[half * 8 + 6] = b.z; v[half * 8 + 7] = b.w;
  }
}

DI void load_row16_bf(const u16* src, int lane, float* v) {
#pragma unroll
  for (int half = 0; half < 2; half++) {
    const u32x4 a = *(const u32x4*)(src + half * 512 + lane * 8);
#pragma unroll
    for (int k = 0; k < 4; k++) { v[half * 8 + 2 * k] = bflo(a[k]); v[half * 8 + 2 * k + 1] = bfhi(a[k]); }
  }
}

DI void phase_ln1(const Params& p, int L) {
  char* ws = p.ws;
  const u16* Y = (const u16*)(ws + OFF_BIG + BIG_Y);
  u16* XB = (u16*)(ws + OFF_XB);
  const float* g = p.ln_g + (size_t)(L * 2 + 0) * 1024; const float* bt = p.ln_b + (size_t)(L * 2 + 0) * 1024;
  const int lane = TIDX() & 63, wave = TIDX() >> 6;
  for (int t = blockIdx.x * 4 + wave; t < T_TOK; t += gridDim.x * 4) {
    float xv[16], yv[16];
    if (L == 0) load_row16(p.x + (size_t)t * 1024, lane, xv);
    else load_row16_bf(XB + (size_t)t * LDX, lane, xv);
    load_row16_bf(Y + (size_t)t * LD_Y, lane, yv);
#pragma unroll
    for (int i = 0; i < 16; i++) xv[i] = DN_ALPHA * xv[i] + yv[i];
    ln_row_store(xv, g, bt, lane, nullptr, XB + (size_t)t * LDX);
  }
}

DI void phase_peer_q(const Params& p, int L, char* smem) {
  char* ws = p.ws;
  EpiBf16 e{(u16*)(ws + OFF_BIG + BIG_PQ), LD_PQ, 2048};
  gemm_phase((const u16*)(ws + OFF_XB), LDX, (const u16*)(ws + OFF_WT_PEER_Q) + (size_t)L * 2048 * LDW, LDW, T_TOK, 2048, 1024, smem, e);
}

DI unsigned f2ord(float f) { const unsigned u = __float_as_uint(f); return (u & 0x80000000u) ? ~u : (u | 0x80000000u); }
DI float ord2f(unsigned o) { const unsigned u = (o & 0x80000000u) ? (o & 0x7fffffffu) : ~o; return __uint_as_float(u); }
DI void topk_insert(unsigned (&Lst)[16], unsigned x) {
#pragma unroll
  for (int j = 0; j < 16; j++) { const unsigned hi = max(Lst[j], x); x = min(Lst[j], x); Lst[j] = hi; }
}

DI void ce_desc(unsigned& a, unsigned& b) { const unsigned hi = max(a, b), lo = min(a, b); a = hi; b = lo; }
DI void sort16_desc(unsigned (&a)[16]) {
#pragma unroll
  for (int k = 2; k <= 16; k <<= 1)
#pragma unroll
    for (int j = k >> 1; j > 0; j >>= 1)
#pragma unroll
      for (int i = 0; i < 16; i++) {
        const int l = i ^ j;
        if (l > i) { if ((i & k) == 0) ce_desc(a[i], a[l]); else ce_desc(a[l], a[i]); }
      }
}
DI void merge16_desc(unsigned (&Lm)[16], const unsigned (&S)[16]) {
#pragma unroll
  for (int i = 0; i < 16; i++) Lm[i] = max(Lm[i], S[15 - i]);
#pragma unroll
  for (int j = 8; j > 0; j >>= 1)
#pragma unroll
    for (int i = 0; i < 16; i++) if ((i & j) == 0) ce_desc(Lm[i], Lm[i + j]);
}

DI void phase_peer_topk(const Params& p, int L, char* smem) {
  char* ws = p.ws;
  const u16* PQ = (const u16*)(ws + OFF_BIG + BIG_PQ);
  const u16* KEYS = (const u16*)(ws + OFF_KEYS) + (size_t)L * 8 * 2 * 128 * 128;
  int* IDX = (int*)(ws + OFF_BIG + BIG_IDX); float* GATE = (float*)(ws + OFF_BIG + BIG_GATE); float* SUE = (float*)(ws + OFF_BIG + BIG_SUE);
  const float* SU = (const float*)(ws + OFF_SU); const float* SV = (const float*)(ws + OFF_SV);
  const int tid = TIDX(), lane = tid & 63, w = tid >> 6, r = lane & 31, hh = lane >> 5;
  constexpr int SST = 132;
  float* sc = (float*)smem;
  unsigned* fin = (unsigned*)(smem + 2 * 64 * SST * 4);
  const int total = (T_TOK / 64) * 8;
  for (int t = blockIdx.x; t < total; t += gridDim.x) {
    const int h = t & 7, tt = t >> 3; const size_t tok0 = (size_t)tt * 64;
    {
      const int pp = w & 1, tb = w >> 1;
      bf16x8 af[8];
      const u16* qrow = PQ + (tok0 + tb * 32 + r) * LD_PQ + h * 256 + pp * 128;
#pragma unroll
      for (int ks = 0; ks < 8; ks++) af[ks] = *(const bf16x8*)(qrow + ks * 16 + hh * 8);
      const u16* kbase = KEYS + ((size_t)(h * 2 + pp) * 128) * 128;
#pragma unroll
      for (int kb = 0; kb < 4; kb++) {
        f32x16 acc;
#pragma unroll
        for (int i = 0; i < 16; i++) acc[i] = 0.f;
#pragma unroll
        for (int ks = 0; ks < 8; ks++) {
          const bf16x8 bfr = *(const bf16x8*)(kbase + (size_t)(kb * 32 + r) * 128 + ks * 16 + hh * 8);
          acc = MFMA32(af[ks], bfr, acc);
        }
#pragma unroll
        for (int i = 0; i < 16; i++) sc[(pp * 64 + tb * 32 + crow(i, hh)) * SST + kb * 32 + r] = acc[i];
      }
    }
    __syncthreads();
    const int tok = tid >> 2, part = tid & 3, pp = part & 1, rng = part >> 1;
    unsigned Lst[16];
    {
      const float* row = sc + (pp * 64 + tok) * SST + rng * 64;
#pragma unroll
      for (int c = 0; c < 4; c++) {
        unsigned S[16];
#pragma unroll
        for (int i = 0; i < 4; i++) {
          const float4 v = *(const float4*)(row + c * 16 + i * 4);
          const unsigned kidx = rng * 64 + c * 16 + i * 4;
          S[4 * i + 0] = (f2ord(v.x) & ~127u) | (kidx + 0);
          S[4 * i + 1] = (f2ord(v.y) & ~127u) | (kidx + 1);
          S[4 * i + 2] = (f2ord(v.z) & ~127u) | (kidx + 2);
          S[4 * i + 3] = (f2ord(v.w) & ~127u) | (kidx + 3);
        }
        sort16_desc(S);
        if (c == 0) {
#pragma unroll
          for (int j = 0; j < 16; j++) Lst[j] = S[j];
        } else merge16_desc(Lst, S);
      }
    }
    {
      unsigned S[16];
#pragma unroll
      for (int j = 0; j < 16; j++) S[j] = (unsigned)__shfl_xor((int)Lst[j], 2);
      merge16_desc(Lst, S);
    }
    unsigned k1[16], k2[16];
#pragma unroll
    for (int j = 0; j < 16; j++) {
      const unsigned o = (unsigned)__shfl_xor((int)Lst[j], 1);
      k1[j] = pp ? o : Lst[j]; k2[j] = pp ? Lst[j] : o;
    }
    if (part < 2) {
#pragma unroll
      for (int j = 0; j < 16; j++) fin[(tok * 2 + part) * 16 + j] = part ? k2[j] : k1[j];
    }
    unsigned L2[16];
    {
      float v1[16], v2[16];
#pragma unroll
      for (int j = 0; j < 16; j++) { v1[j] = ord2f(k1[j] & ~127u); v2[j] = ord2f(k2[j] & ~127u); }
#define CAND(a, b) ((f2ord(v1[a] + v2[b]) & ~255u) | (unsigned)((a) * 16 + (b)))
#pragma unroll
      for (int a = 0; a < 16; a++) L2[a] = CAND(a, 0);
      unsigned S[16];
#pragma unroll
      for (int a = 0; a < 8; a++) { S[a] = CAND(a, 1); S[8 + a] = 0u; }
      merge16_desc(L2, S);
#pragma unroll
      for (int b = 0; b < 8; b++) { S[b] = CAND(0, 8 + b); S[8 + b] = 0u; }
      merge16_desc(L2, S);
      S[0] = CAND(0, 2); S[1] = CAND(1, 2); S[2] = CAND(2, 2); S[3] = CAND(3, 2); S[4] = CAND(4, 2);
      S[5] = CAND(0, 3); S[6] = CAND(1, 3); S[7] = CAND(2, 3); S[8] = CAND(3, 3);
      S[9] = CAND(0, 4); S[10] = CAND(1, 4); S[11] = CAND(2, 4);
      S[12] = CAND(0, 5); S[13] = CAND(1, 5);
      S[14] = CAND(0, 6); S[15] = CAND(1, 6);
      sort16_desc(S);
      merge16_desc(L2, S);
      S[0] = CAND(0, 7); S[1] = CAND(1, 7);
#pragma unroll
      for (int j = 2; j < 16; j++) S[j] = 0u;
      merge16_desc(L2, S);
#undef CAND
    }
    float z = 0.f;
    const float mxv = ord2f(L2[0] & ~255u);
    float ev[16];
#pragma unroll
    for (int j = 0; j < 16; j++) { ev[j] = __expf(ord2f(L2[j] & ~255u) - mxv); z += ev[j]; }
    const float iz = 1.f / z;
    __syncthreads();
    {
      int id[4]; float gv[4], suv[4];
#pragma unroll
      for (int jj = 0; jj < 4; jj++) {
        const unsigned key = (part == 0) ? L2[jj] : (part == 1) ? L2[4 + jj] : (part == 2) ? L2[8 + jj] : L2[12 + jj];
        const float e = (part == 0) ? ev[jj] : (part == 1) ? ev[4 + jj] : (part == 2) ? ev[8 + jj] : ev[12 + jj];
        const int ab = key & 255, a = ab >> 4, b = ab & 15;
        const int i1 = fin[(tok * 2 + 0) * 16 + a] & 127, i2 = fin[(tok * 2 + 1) * 16 + b] & 127;
        id[jj] = i1 * 128 + i2;
        gv[jj] = e * iz * SV[id[jj]];
        suv[jj] = SU[id[jj]];
      }
      const size_t o = (tok0 + tok) * 128 + h * 16 + part * 4;
      *(int4*)(IDX + o) = make_int4(id[0], id[1], id[2], id[3]);
      *(float4*)(GATE + o) = make_float4(gv[0], gv[1], gv[2], gv[3]);
      *(float4*)(SUE + o) = make_float4(suv[0], suv[1], suv[2], suv[3]);
    }
  }
}

DI void ln_row_store16(const float* v, const float* g, const float* bta, int lane, float* outf, u16* outb) {
  float s = 0.f;
#pragma unroll
  for (int i = 0; i < 16; i++) s += v[i];
  const float mu = wave_sum(s) * (1.f / 1024.f);
  float q = 0.f;
#pragma unroll
  for (int i = 0; i < 16; i++) { const float d = v[i] - mu; q += d * d; }
  const float var = wave_sum(q) * (1.f / 1024.f);
  const float rstd = rsqrtf(var + 1e-5f);
  const int c0 = lane * 16;
  float o[16];
#pragma unroll
  for (int k = 0; k < 4; k++) {
    const float4 gg = *(const float4*)(g + c0 + 4 * k), bb = *(const float4*)(bta + c0 + 4 * k);
    o[4 * k + 0] = (v[4 * k + 0] - mu) * rstd * gg.x + bb.x; o[4 * k + 1] = (v[4 * k + 1] - mu) * rstd * gg.y + bb.y;
    o[4 * k + 2] = (v[4 * k + 2] - mu) * rstd * gg.z + bb.z; o[4 * k + 3] = (v[4 * k + 3] - mu) * rstd * gg.w + bb.w;
  }
  if (outf) {
#pragma unroll
    for (int k = 0; k < 4; k++) *(float4*)(outf + c0 + 4 * k) = make_float4(o[4 * k], o[4 * k + 1], o[4 * k + 2], o[4 * k + 3]);
  }
  if (outb) {
    u32x4 a, b;
    a[0] = pack2(o[0], o[1]); a[1] = pack2(o[2], o[3]); a[2] = pack2(o[4], o[5]); a[3] = pack2(o[6], o[7]);
    b[0] = pack2(o[8], o[9]); b[1] = pack2(o[10], o[11]); b[2] = pack2(o[12], o[13]); b[3] = pack2(o[14], o[15]);
    *(u32x4*)(outb + c0) = a; *(u32x4*)(outb + c0 + 8) = b;
  }
}
DI void phase_peer_gather(const Params& p, int L, bool dry = false) {
  char* ws = p.ws;
  const int* IDX = (const int*)(ws + OFF_BIG + BIG_IDX); const float* GATE = (const float*)(ws + OFF_BIG + BIG_GATE);
  const float* SUE = (const float*)(ws + OFF_BIG + BIG_SUE);
  const unsigned char* U8 = (const unsigned char*)(ws + OFF_UB); const unsigned char* V8 = (const unsigned char*)(ws + OFF_VB);
  u16* XB = (u16*)(ws + OFF_XB);
  const float* g = p.ln_g + (size_t)(L * 2 + 1) * 1024; const float* bt = p.ln_b + (size_t)(L * 2 + 1) * 1024;
  const int lane = TIDX() & 63, wave = TIDX() >> 6;
  const int hh = lane >> 5, b4 = (lane >> 4) & 1, b3 = (lane >> 3) & 1;
  const int esel = lane >> 3;
  for (int t = blockIdx.x * 4 + wave; t < T_TOK; t += gridDim.x * 4) {
    f32x2 xv2[8], yv2[8];
    {
      const u32x4* xp = (const u32x4*)(XB + (size_t)t * LDX + lane * 16);
#pragma unroll
      for (int k = 0; k < 2; k++) { const u32x4 a = xp[k];
#pragma unroll
        for (int q = 0; q < 4; q++) { xv2[4 * k + q][0] = bflo(a[q]); xv2[4 * k + q][1] = bfhi(a[q]); } }
    }
#pragma unroll
    for (int i = 0; i < 8; i++) { yv2[i][0] = 0.f; yv2[i][1] = 0.f; }
    const int idx_lo = IDX[(size_t)t * 128 + lane], idx_hi = IDX[(size_t)t * 128 + 64 + lane];
    for (int bch = 0; bch < 16; bch++) {
      const int isrc = (bch < 8) ? idx_lo : idx_hi;
      u32x2 ur[8], vr[8];
#pragma unroll
      for (int jj = 0; jj < 8; jj++) {
        const int e = __builtin_amdgcn_readlane(isrc, ((bch & 7) * 8 + jj));
        ur[jj] = *(const u32x2*)(U8 + (size_t)e * 512 + lane * 8);
        vr[jj] = *(const u32x2*)(V8 + (size_t)e * 512 + lane * 8);
      }
      const float gt = GATE[(size_t)t * 128 + bch * 8 + esel];
      const float sue = SUE[(size_t)t * 128 + bch * 8 + esel];
      float pd[8];
#pragma unroll
      for (int jj = 0; jj < 8; jj++) {
        f32x2 a2 = {0.f, 0.f};
#pragma unroll
        for (int k = 0; k < 2; k++) {
          a2 = __builtin_elementwise_fma(__builtin_amdgcn_cvt_scalef32_pk_f32_fp4(ur[jj][k], 1.0f, 0), xv2[4 * k + 0], a2);
          a2 = __builtin_elementwise_fma(__builtin_amdgcn_cvt_scalef32_pk_f32_fp4(ur[jj][k], 1.0f, 1), xv2[4 * k + 1], a2);
          a2 = __builtin_elementwise_fma(__builtin_amdgcn_cvt_scalef32_pk_f32_fp4(ur[jj][k], 1.0f, 2), xv2[4 * k + 2], a2);
          a2 = __builtin_elementwise_fma(__builtin_amdgcn_cvt_scalef32_pk_f32_fp4(ur[jj][k], 1.0f, 3), xv2[4 * k + 3], a2);
        }
        pd[jj] = a2[0] + a2[1];
      }
      float q4[4], q2[2], q1;
#pragma unroll
      for (int j = 0; j < 4; j++) { const float send = hh ? pd[j] : pd[j + 4]; const float recv = __shfl_xor(send, 32); q4[j] = (hh ? pd[j + 4] : pd[j]) + recv; }
#pragma unroll
      for (int j = 0; j < 2; j++) { const float send = b4 ? q4[j] : q4[j + 2]; const float recv = __shfl_xor(send, 16); q2[j] = (b4 ? q4[j + 2] : q4[j]) + recv; }
      { const float send = b3 ? q2[0] : q2[1]; const float recv = __shfl_xor(send, 8); q1 = (b3 ? q2[1] : q2[0]) + recv; }
      q1 += __shfl_xor(q1, 4); q1 += __shfl_xor(q1, 2); q1 += __shfl_xor(q1, 1);
      const float hv = q1 * sue;
      const float cf = gt * 0.5f * hv * (1.f + erff(hv * 0.70710678118654752f));
#pragma unroll
      for (int jj = 0; jj < 8; jj++) {
        const float c = __int_as_float(__builtin_amdgcn_readlane(__float_as_int(cf), jj * 8));
        const f32x2 c2 = {c, c};
#pragma unroll
        for (int k = 0; k < 2; k++) {
          yv2[4 * k + 0] = __builtin_elementwise_fma(__builtin_amdgcn_cvt_scalef32_pk_f32_fp4(vr[jj][k], 1.0f, 0), c2, yv2[4 * k + 0]);
          yv2[4 * k + 1] = __builtin_elementwise_fma(__builtin_amdgcn_cvt_scalef32_pk_f32_fp4(vr[jj][k], 1.0f, 1), c2, yv2[4 * k + 1]);
          yv2[4 * k + 2] = __builtin_elementwise_fma(__builtin_amdgcn_cvt_scalef32_pk_f32_fp4(vr[jj][k], 1.0f, 2), c2, yv2[4 * k + 2]);
          yv2[4 * k + 3] = __builtin_elementwise_fma(__builtin_amdgcn_cvt_scalef32_pk_f32_fp4(vr[jj][k], 1.0f, 3), c2, yv2[4 * k + 3]);
        }
      }
    }
    float xv[16];
#pragma unroll
    for (int i = 0; i < 8; i++) { xv[2 * i] = DN_ALPHA * xv2[i][0] + yv2[i][0]; xv[2 * i + 1] = DN_ALPHA * xv2[i][1] + yv2[i][1]; }
    if (dry) { if (xv[0] == 1234.5678f) XB[t] = 1; }
    else if (L == 3) ln_row_store16(xv, g, bt, lane, p.out + (size_t)t * 1024, nullptr);
    else ln_row_store16(xv, g, bt, lane, nullptr, XB + (size_t)t * LDX);
  }
}

DI bool phase_applies(int L, int ph) {
  const int kind = L % 3;
  if (ph >= 2 && ph <= 4) return kind == 2;
  if (ph == 6) return kind == 1;
  return true;
}
DI void run_phase(const Params& p, int L, int ph, char* smem) {
  const int kind = L % 3;
  switch (ph) {
    case 0: phase_prep(p, smem); break;
    case 1: phase_inproj(p, L, smem); break;
    case 2: phase_mla_norm(p, smem); break;
    case 3: phase_mla_up(p, smem); break;
    case 4: phase_mla_ropeq(p); break;
    case 5: if (kind == 0) phase_attn_swa(p, L / 3, smem); else if (kind == 1) phase_attn_dil(p, smem); else phase_attn_mla(p, smem); break;
    case 6: phase_dil_mix(p); break;
    case 7: phase_outproj(p, L, smem); break;
    case 8: phase_ln1(p, L); break;
    case 9: phase_peer_q(p, L, smem); break;
    case 10: phase_peer_topk(p, L, smem); break;
    case 11: phase_peer_gather(p, L); break;
  }
}

#if ONE_LAUNCH
#ifndef DUP_LAYERS
#define DUP_LAYERS 15
#endif
#ifndef DUP_MASK
#define DUP_MASK 0
#endif
typedef const __attribute__((address_space(4))) Params* KargPtr;
#if defined(__HIP_DEVICE_COMPILE__)
#define LOAD_PARAMS() KargPtr q_ = kp_; asm volatile("" : "+s"(q_)); Params lp_; __builtin_memcpy(&lp_, (const void*)q_, sizeof(Params))
#else
#define LOAD_PARAMS() const Params lp_ = p
#endif
#define PHASE(L, ph) do { LOAD_PARAMS(); run_phase(lp_, (L), (ph), smem); xcd_barrier2((unsigned*)(lp_.ws + OFF_BAR)); } while (0)
__global__ void __launch_bounds__(NT, 2) mega_kernel(Params p) {
  __shared__ __attribute__((aligned(16))) char smem[SMEM_BYTES];
  cg::grid_group grid = cg::this_grid();
  if (TIDX() == 0) g_xb_words = make_uint4(0u, 0u, 0u, 0u);
  __syncthreads();
#if defined(__HIP_DEVICE_COMPILE__)
  KargPtr kp_ = (KargPtr)__builtin_amdgcn_kernarg_segment_ptr();
#endif
  { LOAD_PARAMS(); (void)xcd_barrier_post((unsigned*)(lp_.ws + OFF_BAR), (volatile LAS unsigned*)&g_xb_words); }
  { LOAD_PARAMS(); run_phase(lp_, 0, 0, smem); }
  grid.sync();
  PHASE(0, 1); PHASE(0, 5); PHASE(0, 7); PHASE(0, 8); PHASE(0, 9); PHASE(0, 10); PHASE(0, 11);
  PHASE(1, 1); PHASE(1, 5); PHASE(1, 6); PHASE(1, 7); PHASE(1, 8); PHASE(1, 9); PHASE(1, 10); PHASE(1, 11);
  PHASE(2, 1); PHASE(2, 2); PHASE(2, 3); PHASE(2, 5); PHASE(2, 7); PHASE(2, 8); PHASE(2, 9); PHASE(2, 10); PHASE(2, 11);
  PHASE(3, 1); PHASE(3, 5); PHASE(3, 7); PHASE(3, 8); PHASE(3, 9); PHASE(3, 10);
  { LOAD_PARAMS(); run_phase(lp_, 3, 11, smem); }
}
#else
__global__ void __launch_bounds__(NT, 2) phase_kernel(Params p, int L, int ph) {
  __shared__ __attribute__((aligned(16))) char smem[SMEM_BYTES];
  run_phase(p, L, ph, smem);
}
#endif

extern "C" void kernel_launch(void* const* d_in, const int* in_sizes, int n_in, void* d_out, int out_size, void* d_ws,
                              size_t ws_size, hipStream_t stream) {
  Params p{};
  p.x = (const float*)d_in[0]; p.rel_bias = (const float*)d_in[1]; p.ln_g = (const float*)d_in[2]; p.ln_b = (const float*)d_in[3];
  p.swa_w_in = (const float*)d_in[4]; p.swa_sinks = (const float*)d_in[5]; p.swa_w_out = (const float*)d_in[6];
  p.dil_w_in = (const float*)d_in[7]; p.dil_w_out = (const float*)d_in[8];
  p.mla_w_in = (const float*)d_in[9]; p.mla_q_norm = (const float*)d_in[10]; p.mla_w_uq = (const float*)d_in[11];
  p.mla_kv_norm = (const float*)d_in[12]; p.mla_w_ukv = (const float*)d_in[13]; p.mla_w_out = (const float*)d_in[14];
  p.peer_w_q = (const float*)d_in[15]; p.peer_keys = (const float*)d_in[16]; p.peer_u = (const float*)d_in[17]; p.peer_v = (const float*)d_in[18];
  p.out = (float*)d_out; p.ws = (char*)d_ws;
  if (ws_size < WS_TOTAL) { fprintf(stderr, "workspace too small: %zu < %zu\n", ws_size, (size_t)WS_NEEDED); return; }
#if ONE_LAUNCH
  static int grid_blocks = 0;
  if (!grid_blocks) {
    int dev = 0, cus = 0, per_cu = 0;
    hipGetDevice(&dev);
    hipDeviceGetAttribute(&cus, hipDeviceAttributeMultiprocessorCount, dev);
    hipOccupancyMaxActiveBlocksPerMultiprocessor(&per_cu, mega_kernel, NT, 0);
    if (per_cu > 2) per_cu = 2;
    if (per_cu < 1) per_cu = 1;
    grid_blocks = cus * per_cu;
  }
  (void)hipMemsetAsync((char*)d_ws + OFF_BAR, 0, XCD_BAR_WORDS * 4, stream);
  void* args[] = {&p};
  hipError_t e = hipLaunchCooperativeKernel((void*)mega_kernel, dim3(grid_blocks), dim3(NT), args, 0, stream);
  if (e != hipSuccess) fprintf(stderr, "cooperative launch failed: %s (grid %d)\n", hipGetErrorString(e), grid_blocks);
#else
  const int grid_blocks = 512;
  phase_kernel<<<grid_blocks, NT, 0, stream>>>(p, 0, 0);
  for (int L = 0; L < 4; L++)
    for (int ph = 1; ph <= 11; ph++) {
      const int kind = L % 3;
      bool ok = true;
      if (ph >= 2 && ph <= 4) ok = (kind == 2);
      if (ph == 6) ok = (kind == 1);
      if (ok) phase_kernel<<<grid_blocks, NT, 0, stream>>>(p, L, ph);
    }
#endif
}
```

```cpp
#include <hip/hip_runtime.h>
#include <hip/hip_cooperative_groups.h>
#include <cstdio>
#include <cstdint>
namespace cg = cooperative_groups;

#ifndef ZERO_ATTN_MASK
#define ZERO_ATTN_MASK 0
#endif
#ifndef ZERO_PEER_MASK
#define ZERO_PEER_MASK 0
#endif
#ifndef ONE_LAUNCH
#define ONE_LAUNCH 1
#endif

typedef unsigned short u16;
typedef __attribute__((ext_vector_type(8))) short bf16x8;
typedef __attribute__((ext_vector_type(4))) short s16x4;
typedef __attribute__((ext_vector_type(16))) float f32x16;
typedef __attribute__((ext_vector_type(4))) unsigned u32x4;
typedef __attribute__((ext_vector_type(2))) float f32x2;
#define DI __device__ __forceinline__
__device__ __forceinline__ int TIDX() { int t = (int)threadIdx.x; asm volatile("" : "+v"(t)); return t; }
#define MFMA32(a, b, c) __builtin_amdgcn_mfma_f32_32x32x16_bf16((a), (b), (c), 0, 0, 0)
#define MFMA16(a, b, c) __builtin_amdgcn_mfma_f32_16x16x32_bf16((a), (b), (c), 0, 0, 0)
typedef __attribute__((ext_vector_type(4))) float f32x4;

constexpr int NT = 256;
constexpr int T_TOK = 32768;
constexpr int SEQ = 8192;
constexpr int DM = 1024;
constexpr float DN_ALPHA = 1.681792830507429f;

constexpr size_t MiB = 1024ull * 1024ull;
constexpr int LDX = 1088;
constexpr int LDW = 1088;
constexpr int LD_SWA = 1280;
constexpr int LD_DIL = 9352;
constexpr int LD_PQ = 2120;
constexpr int LD_Y = 1056;
constexpr int LD_QM = 1608;
constexpr int LD_KVM = 2120;
constexpr size_t OFF_WT_SWA_IN = 0;
constexpr size_t OFF_WT_SWA_OUT = OFF_WT_SWA_IN + 2ull * 1280 * LDW * 2;
constexpr size_t OFF_WT_DIL_IN = OFF_WT_SWA_OUT + 2ull * 1024 * LDW * 2;
constexpr size_t OFF_WT_DIL_OUT = OFF_WT_DIL_IN + 9216ull * LDW * 2;
constexpr size_t OFF_WT_MLA_IN = OFF_WT_DIL_OUT + 1024ull * LDW * 2;
constexpr size_t OFF_WT_MLA_UQ = OFF_WT_MLA_IN + 512ull * LDW * 2;
constexpr size_t OFF_WT_MLA_UKV = OFF_WT_MLA_UQ + 1536ull * 256 * 2;
constexpr size_t OFF_WT_MLA_OUT = OFF_WT_MLA_UKV + 2048ull * 128 * 2;
constexpr size_t OFF_WT_PEER_Q = OFF_WT_MLA_OUT + 1024ull * LDW * 2;
constexpr size_t OFF_KEYS = OFF_WT_PEER_Q + 4ull * 2048 * LDW * 2;
constexpr size_t OFF_WT_END = OFF_KEYS + 4ull * 8 * 2 * 128 * 128 * 2;
constexpr size_t OFF_XF = 56 * MiB;
constexpr size_t OFF_XB = OFF_XF + 128 * MiB;
constexpr size_t OFF_AO = OFF_XB + 68 * MiB;
constexpr size_t OFF_UB = OFF_AO + 68 * MiB;
constexpr size_t OFF_VB = OFF_UB + 32 * MiB;
constexpr size_t OFF_LSE = OFF_VB + 16 * MiB;
constexpr size_t OFF_BIG = OFF_LSE + 6 * MiB;
constexpr size_t WS_NEEDED = OFF_BIG + 585 * MiB;
static_assert(OFF_WT_END <= OFF_XF, "weights overflow");
static_assert((size_t)T_TOK * LD_DIL * 2 <= 585 * MiB, "big overflow");
constexpr size_t BIG_Y = 0;
constexpr size_t BIG_PQ = 192 * MiB;
constexpr size_t BIG_IDX = 384 * MiB;
constexpr size_t BIG_GATE = 416 * MiB;
constexpr size_t BIG_SUE = 448 * MiB;
constexpr size_t OFF_SU = OFF_UB + 16 * MiB;
constexpr size_t OFF_SV = OFF_SU + 65536;
constexpr size_t BIG_CF = 0;
constexpr size_t BIG_CQ = 64 * MiB;
constexpr size_t BIG_CKV = 96 * MiB;
constexpr size_t BIG_KR = 112 * MiB;
constexpr size_t BIG_QM = 128 * MiB;
constexpr size_t BIG_KVM = 256 * MiB;

constexpr size_t OFF_BAR = 960 * MiB;
constexpr size_t WS_TOTAL = OFF_BAR + 65536;
constexpr int SMEM_BYTES = 77824;

struct Params {
  const float* x; const float* rel_bias; const float* ln_g; const float* ln_b;
  const float* swa_w_in; const float* swa_sinks; const float* swa_w_out;
  const float* dil_w_in; const float* dil_w_out;
  const float* mla_w_in; const float* mla_q_norm; const float* mla_w_uq; const float* mla_kv_norm;
  const float* mla_w_ukv; const float* mla_w_out;
  const float* peer_w_q; const float* peer_keys; const float* peer_u; const float* peer_v;
  float* out; char* ws;
};

typedef __bf16 bf16v2 __attribute__((ext_vector_type(2)));
typedef float f32v2 __attribute__((ext_vector_type(2)));
DI unsigned pack2(float a, float b) { f32v2 v = {a, b}; return __builtin_bit_cast(unsigned, __builtin_convertvector(v, bf16v2)); }
DI u16 f2bf(float x) { return (u16)(pack2(x, 0.f) & 0xffffu); }
DI float bf2f(u16 b) { return __uint_as_float(((unsigned)b) << 16); }
DI float bflo(unsigned w) { return __uint_as_float(w << 16); }
DI float bfhi(unsigned w) { return __uint_as_float(w & 0xffff0000u); }
DI int crow(int i, int hh) { return (i & 3) + 8 * (i >> 2) + 4 * hh; }
DI float wave_sum(float v) {
#pragma unroll
  for (int o = 32; o >= 1; o >>= 1) v += __shfl_xor(v, o);
  return v;
}


#define XB_TMO      128
#define XB_XCNT(j)  (256  + 64 * (j))
#define XB_XSUB(j)  (1280 + 64 * (j))
#define XB_XGEN(j)  (2304 + 64 * (j))
#define XB_TOP      3328
#define XB_TOPGEN   3392
#define XCD_BAR_WORDS 3456
#define XB_SPIN_CAP (1u << 18)
#define LAS __attribute__((address_space(3)))
DI unsigned xb_ld(unsigned* p)              { return __hip_atomic_load(p, __ATOMIC_RELAXED, __HIP_MEMORY_SCOPE_AGENT); }
DI unsigned xb_add(unsigned* p, unsigned v) { return __hip_atomic_fetch_add(p, v, __ATOMIC_RELAXED, __HIP_MEMORY_SCOPE_AGENT); }
DI unsigned xb_xcc_id() { return (unsigned)__builtin_amdgcn_s_getreg((3 << 11) | 20) & 0xFu; }
#define XB_SPIN(cond, bar) do { unsigned _sp = 0; while (cond) { __builtin_amdgcn_s_sleep(1); \
    if ((++_sp & 255u) == 0u) { if (xb_ld(&(bar)[XB_TMO])) break; if (_sp > XB_SPIN_CAP) { atomicAdd(&(bar)[XB_TMO], 1u); break; } } } } while (0)
struct XcdBarrier { unsigned* bar; unsigned x; volatile LAS unsigned* st; };
DI XcdBarrier xcd_barrier_post(unsigned* bar, volatile LAS unsigned* st) {
  XcdBarrier b; b.bar = bar; b.x = xb_xcc_id(); b.st = st;
  if (TIDX() == 0) (void)xb_add(&bar[XB_XCNT(b.x)], 1u);
  return b;
}
DI void xcd_barrier_complete(unsigned* bar, unsigned x, unsigned& nloc, unsigned& nx) {
  const unsigned G = gridDim.x * gridDim.y * gridDim.z;
  unsigned sum, cnt, mine, sp = 0u;
  for (;;) {
    sum = 0u; cnt = 0u; mine = 0u;
#pragma unroll
    for (unsigned j = 0; j < 16; ++j) { const unsigned c = xb_ld(&bar[XB_XCNT(j)]); sum += c; cnt += (c > 0u) ? 1u : 0u; mine = (j == x) ? c : mine; }
    if (sum == G) break;
    __builtin_amdgcn_s_sleep(1);
    if ((++sp & 255u) == 0u) { if (xb_ld(&bar[XB_TMO])) break; if (sp > XB_SPIN_CAP) { atomicAdd(&bar[XB_TMO], 1u); break; } }
  }
  nloc = mine > 0u ? mine : 1u; nx = cnt > 0u ? cnt : 1u;
}
__shared__ uint4 g_xb_words;
DI void xcd_barrier(const XcdBarrier& b);
DI void xcd_barrier2(unsigned* bar) {
  XcdBarrier b; b.bar = bar; b.x = xb_xcc_id(); b.st = (volatile LAS unsigned*)&g_xb_words;
  xcd_barrier(b);
}
DI void xcd_barrier(const XcdBarrier& b) {
  asm volatile("s_waitcnt vmcnt(0)" ::: "memory");
  __syncthreads();
  if (TIDX() == 0) {
    unsigned* bar = b.bar;
    __builtin_amdgcn_s_waitcnt(0);
    unsigned nloc = b.st[0], nx = b.st[1];
    if (nloc == 0u) { xcd_barrier_complete(bar, b.x, nloc, nx); b.st[0] = nloc; b.st[1] = nx; }
    const unsigned old = xb_add(&bar[XB_XSUB(b.x)], 1u);
    const unsigned gen = old / nloc;
    if (old + 1u == (gen + 1u) * nloc) {
      __builtin_amdgcn_fence(__ATOMIC_RELEASE, "agent");
      asm volatile("s_waitcnt vmcnt(0)" ::: "memory");
      const unsigned og = xb_add(&bar[XB_TOP], 1u);
      const unsigned tg = og / nx;
      if (og + 1u == (tg + 1u) * nx) xb_add(&bar[XB_TOPGEN], 1u);
      else XB_SPIN(xb_ld(&bar[XB_TOPGEN]) == tg, bar);
      __builtin_amdgcn_fence(__ATOMIC_ACQUIRE, "agent");
      xb_add(&bar[XB_XGEN(b.x)], 1u);
      asm volatile("s_waitcnt vmcnt(0)" ::: "memory");
    } else {
      XB_SPIN(xb_ld(&bar[XB_XGEN(b.x)]) == gen, bar);
      __builtin_amdgcn_fence(__ATOMIC_ACQUIRE, "agent");
      asm volatile("s_waitcnt vmcnt(0)" ::: "memory");
    }
  }
  __syncthreads();
}

DI void transpose_convert(const float* W, u16* Wt, int K, int N, int ldt, char* smem) {
  float (*tile)[33] = (float (*)[33])smem;
  const int tilesN = N / 32, tilesK = K / 64;
  const int tx = TIDX() & 31, ty = TIDX() >> 5;
  for (int t = blockIdx.x; t < tilesK * tilesN; t += gridDim.x) {
    const int tk = t / tilesN, tn = t % tilesN;
#pragma unroll
    for (int i = 0; i < 8; i++) tile[ty + 8 * i][tx] = W[(size_t)(tk * 64 + ty + 8 * i) * N + tn * 32 + tx];
    __syncthreads();
#pragma unroll
    for (int i = 0; i < 4; i++) {
      const int n = ty + 8 * i;
      *(unsigned*)(Wt + (size_t)(tn * 32 + n) * ldt + tk * 64 + 2 * tx) = pack2(tile[2 * tx][n], tile[2 * tx + 1][n]);
    }
    __syncthreads();
  }
}
DI void convert_f32_bf16(const float* src, u16* dst, size_t n) {
  const size_t n8 = n / 8;
  for (size_t i = (size_t)blockIdx.x * NT + TIDX(); i < n8; i += (size_t)gridDim.x * NT) {
    const float4 a = ((const float4*)src)[2 * i], b = ((const float4*)src)[2 * i + 1];
    uint4 o; o.x = pack2(a.x, a.y); o.y = pack2(a.z, a.w); o.z = pack2(b.x, b.y); o.w = pack2(b.z, b.w);
    ((uint4*)dst)[i] = o;
  }
}


DI void convert_rows_bf16(const float* src, u16* dst, int rows, int ldd) {
  const size_t n8 = (size_t)rows * 128;
  for (size_t i = (size_t)blockIdx.x * NT + TIDX(); i < n8; i += (size_t)gridDim.x * NT) {
    const size_t row = i >> 7; const int c = (int)(i & 127);
    const float4 a = ((const float4*)src)[2 * i], b = ((const float4*)src)[2 * i + 1];
    uint4 o; o.x = pack2(a.x, a.y); o.y = pack2(a.z, a.w); o.z = pack2(b.x, b.y); o.w = pack2(b.z, b.w);
    *(uint4*)(dst + row * ldd + c * 8) = o;
  }
}
DI void convert_rows_fp8(const float* src, unsigned char* dst, float* dq, int nrows) {
  const int lane = TIDX() & 63, wave = TIDX() >> 6;
  for (int row = blockIdx.x * 4 + wave; row < nrows; row += gridDim.x * 4) {
    const float4* sp = (const float4*)(src + (size_t)row * 1024 + lane * 16);
    const float4 a = sp[0], b = sp[1], c = sp[2], d = sp[3];
    float m = fmaxf(fmaxf(fmaxf(fabsf(a.x), fabsf(a.y)), fmaxf(fabsf(a.z), fabsf(a.w))), fmaxf(fmaxf(fabsf(b.x), fabsf(b.y)), fmaxf(fabsf(b.z), fabsf(b.w))));
    m = fmaxf(m, fmaxf(fmaxf(fmaxf(fabsf(c.x), fabsf(c.y)), fmaxf(fabsf(c.z), fabsf(c.w))), fmaxf(fmaxf(fabsf(d.x), fabsf(d.y)), fmaxf(fabsf(d.z), fabsf(d.w)))));
#pragma unroll
    for (int o = 32; o >= 1; o >>= 1) m = fmaxf(m, __shfl_xor(m, o));
    const float sc = (m > 0.f) ? 448.f / m : 1.f;
    u32x4 o;
    int w;
    w = 0; w = __builtin_amdgcn_cvt_pk_fp8_f32(a.x * sc, a.y * sc, w, false); w = __builtin_amdgcn_cvt_pk_fp8_f32(a.z * sc, a.w * sc, w, true); o[0] = (unsigned)w;
    w = 0; w = __builtin_amdgcn_cvt_pk_fp8_f32(b.x * sc, b.y * sc, w, false); w = __builtin_amdgcn_cvt_pk_fp8_f32(b.z * sc, b.w * sc, w, true); o[1] = (unsigned)w;
    w = 0; w = __builtin_amdgcn_cvt_pk_fp8_f32(c.x * sc, c.y * sc, w, false); w = __builtin_amdgcn_cvt_pk_fp8_f32(c.z * sc, c.w * sc, w, true); o[2] = (unsigned)w;
    w = 0; w = __builtin_amdgcn_cvt_pk_fp8_f32(d.x * sc, d.y * sc, w, false); w = __builtin_amdgcn_cvt_pk_fp8_f32(d.z * sc, d.w * sc, w, true); o[3] = (unsigned)w;
    *(u32x4*)(dst + (size_t)row * 1024 + lane * 16) = o;
    if (lane == 0) dq[row] = (m > 0.f) ? m * (1.f / 448.f) : 1.f;
  }
}

typedef __attribute__((ext_vector_type(2))) unsigned u32x2;
DI void convert_rows_fp4(const float* src, unsigned char* dst, float* dq, int nrows) {
  const int lane = TIDX() & 63, wave = TIDX() >> 6;
  for (int row = blockIdx.x * 4 + wave; row < nrows; row += gridDim.x * 4) {
    const float4* sp = (const float4*)(src + (size_t)row * 1024 + lane * 16);
    const float4 a = sp[0], b = sp[1], c = sp[2], d = sp[3];
    float m = fmaxf(fmaxf(fmaxf(fabsf(a.x), fabsf(a.y)), fmaxf(fabsf(a.z), fabsf(a.w))), fmaxf(fmaxf(fabsf(b.x), fabsf(b.y)), fmaxf(fabsf(b.z), fabsf(b.w))));
    m = fmaxf(m, fmaxf(fmaxf(fmaxf(fabsf(c.x), fabsf(c.y)), fmaxf(fabsf(c.z), fabsf(c.w))), fmaxf(fmaxf(fabsf(d.x), fabsf(d.y)), fmaxf(fabsf(d.z), fabsf(d.w)))));
#pragma unroll
    for (int o = 32; o >= 1; o >>= 1) m = fmaxf(m, __shfl_xor(m, o));
    const float sc = (m > 0.f) ? 6.f / m : 1.f;
    unsigned w0 = 0, w1 = 0;
    w0 = __builtin_amdgcn_cvt_scalef32_pk_fp4_f32(w0, a.x * sc, a.y * sc, 1.0f, 0);
    w0 = __builtin_amdgcn_cvt_scalef32_pk_fp4_f32(w0, a.z * sc, a.w * sc, 1.0f, 1);
    w0 = __builtin_amdgcn_cvt_scalef32_pk_fp4_f32(w0, b.x * sc, b.y * sc, 1.0f, 2);
    w0 = __builtin_amdgcn_cvt_scalef32_pk_fp4_f32(w0, b.z * sc, b.w * sc, 1.0f, 3);
    w1 = __builtin_amdgcn_cvt_scalef32_pk_fp4_f32(w1, c.x * sc, c.y * sc, 1.0f, 0);
    w1 = __builtin_amdgcn_cvt_scalef32_pk_fp4_f32(w1, c.z * sc, c.w * sc, 1.0f, 1);
    w1 = __builtin_amdgcn_cvt_scalef32_pk_fp4_f32(w1, d.x * sc, d.y * sc, 1.0f, 2);
    w1 = __builtin_amdgcn_cvt_scalef32_pk_fp4_f32(w1, d.z * sc, d.w * sc, 1.0f, 3);
    u32x2 o; o[0] = w0; o[1] = w1;
    *(u32x2*)(dst + (size_t)row * 512 + lane * 8) = o;
    if (lane == 0) dq[row] = (m > 0.f) ? m * (1.f / 6.f) : 1.f;
  }
}

template <class Epi>
DI void gemm_phase(const u16* A, int lda, const u16* Bt, int ldb, int M, int Npad, int K, char* smem, Epi epi) {
  const int tilesN = Npad / 128, tilesM = M / 128;
  const int tid = TIDX(), lane = tid & 63, wave = tid >> 6, r = lane & 31, hh = lane >> 5;
  const int wm = wave >> 1, wn = wave & 1, l15 = lane & 15, lq = lane >> 4;
  char* As = smem; char* Bs = smem + 128 * 144;
  const int nk = K / 64;
  const int xcd = blockIdx.x & 7, local = blockIdx.x >> 3, nloc = gridDim.x >> 3;
  const int ulim = (tilesM >> 3) * tilesN;
  u32x4 ra0[4], rb0[4];
  if (local < ulim) {
    const u16* Ag = A + (size_t)(((local / tilesN) * 8 + xcd) * 128) * lda;
    const u16* Bg = Bt + (size_t)((local % tilesN) * 128) * ldb;
#pragma unroll
    for (int i = 0; i < 4; i++) { const int c = tid + 256 * i, row = c >> 3, kc = c & 7;
      ra0[i] = *(const u32x4*)(Ag + (size_t)row * lda + kc * 8); rb0[i] = *(const u32x4*)(Bg + (size_t)row * ldb + kc * 8); }
  }
  for (int u = local; u < ulim; u += nloc) {
    const int tm = (u / tilesN) * 8 + xcd, tn = u % tilesN;
    const int un = u + nloc;
    const u16* Agn = A + (size_t)((((un < ulim ? un : u) / tilesN) * 8 + xcd) * 128) * lda;
    const u16* Bgn = Bt + (size_t)(((un < ulim ? un : u) % tilesN) * 128) * ldb;
    f32x4 acc[4][4];
#pragma unroll
    for (int a = 0; a < 4; a++)
#pragma unroll
      for (int b = 0; b < 4; b++)
#pragma unroll
        for (int i = 0; i < 4; i++) acc[a][b][i] = 0.f;
    const u16* Ag = A + (size_t)(tm * 128) * lda;
    const u16* Bg = Bt + (size_t)(tn * 128) * ldb;
#define GLOAD(RA, RB, K0) _Pragma("unroll") for (int i = 0; i < 4; i++) { const int c = tid + 256 * i, row = c >> 3, kc = c & 7; \
      RA[i] = *(const u32x4*)(Ag + (size_t)row * lda + (K0) + kc * 8); RB[i] = *(const u32x4*)(Bg + (size_t)row * ldb + (K0) + kc * 8); }
#define LWRITE(RA, RB, BUF) _Pragma("unroll") for (int i = 0; i < 4; i++) { const int c = tid + 256 * i, row = c >> 3, kc = c & 7; \
      *(u32x4*)(As + (BUF) * 36864 + row * 144 + kc * 16) = RA[i]; *(u32x4*)(Bs + (BUF) * 36864 + row * 144 + kc * 16) = RB[i]; }
#define COMPUTE(BUF) _Pragma("unroll") for (int s = 0; s < 2; s++) { bf16x8 af[4], bfr[4]; \
      _Pragma("unroll") for (int mi = 0; mi < 4; mi++) af[mi] = *(const bf16x8*)(As + (BUF) * 36864 + (wm * 64 + mi * 16 + l15) * 144 + (s * 32 + lq * 8) * 2); \
      _Pragma("unroll") for (int ni = 0; ni < 4; ni++) bfr[ni] = *(const bf16x8*)(Bs + (BUF) * 36864 + (wn * 64 + ni * 16 + l15) * 144 + (s * 32 + lq * 8) * 2); \
      _Pragma("unroll") for (int mi = 0; mi < 4; mi++) _Pragma("unroll") for (int ni = 0; ni < 4; ni++) acc[mi][ni] = MFMA16(bfr[ni], af[mi], acc[mi][ni]); }
    LWRITE(ra0, rb0, 0);
    GLOAD(ra0, rb0, 64);
    __syncthreads();
    for (int kt = 0; kt < nk; kt++) {
      const int cb = kt & 1;
      if (kt + 1 < nk) LWRITE(ra0, rb0, (cb ^ 1));
      if (kt + 2 < nk) { GLOAD(ra0, rb0, (kt + 2) * 64); }
      else if (kt + 2 == nk && un < ulim) {
#pragma unroll
        for (int i = 0; i < 4; i++) { const int c = tid + 256 * i, row = c >> 3, kc = c & 7;
          ra0[i] = *(const u32x4*)(Agn + (size_t)row * lda + kc * 8); rb0[i] = *(const u32x4*)(Bgn + (size_t)row * ldb + kc * 8); }
      }
      __builtin_amdgcn_s_setprio(1);
      COMPUTE(cb);
      __builtin_amdgcn_iglp_opt(1);
      __builtin_amdgcn_s_setprio(0);
      __syncthreads();
    }
#undef GLOAD
#undef LWRITE
#undef COMPUTE
    if (Epi::STAGED) {
      char* Cs = smem;
#pragma unroll
      for (int mi = 0; mi < 4; mi++)
#pragma unroll
        for (int ni = 0; ni < 4; ni++) {
          u32x2 o; o[0] = pack2(acc[mi][ni][0], acc[mi][ni][1]); o[1] = pack2(acc[mi][ni][2], acc[mi][ni][3]);
          *(u32x2*)(Cs + (wm * 64 + mi * 16 + l15) * 272 + (wn * 64 + ni * 16 + lq * 4) * 2) = o;
        }
      __syncthreads();
#pragma unroll
      for (int i = 0; i < 8; i++) {
        const int c = tid + 256 * i, row = c >> 4, ch = c & 15;
        const u32x4 v = *(const u32x4*)(Cs + row * 272 + ch * 16);
        epi.store16(tm * 128 + row, tn * 128 + ch * 8, v);
      }
      __syncthreads();
    } else {
#pragma unroll
      for (int mi = 0; mi < 4; mi++)
#pragma unroll
        for (int ni = 0; ni < 4; ni++) {
          const int row = tm * 128 + wm * 64 + mi * 16 + l15;
          const int col = tn * 128 + wn * 64 + ni * 16 + lq * 4;
          epi(row, col, acc[mi][ni][0], acc[mi][ni][1], acc[mi][ni][2], acc[mi][ni][3]);
        }
    }
  }
}
struct EpiBf16 {
  static constexpr bool STAGED = true;
  u16* C; int ldc; int N;
  DI void store16(int row, int col, u32x4 v) const { if (col < N) *(u32x4*)(C + (size_t)row * ldc + col) = v; }
  DI void operator()(int row, int col, float a, float b, float c, float d) const {
    if (col < N) { uint2 o; o.x = pack2(a, b); o.y = pack2(c, d); *(uint2*)(C + (size_t)row * ldc + col) = o; }
  }
};
struct EpiF32 {
  static constexpr bool STAGED = false;
  float* C; int ldc; int N;
  DI void store16(int, int, u32x4) const {}
  DI void operator()(int row, int col, float a, float b, float c, float d) const {
    if (col < N) { float4 o = {a, b, c, d}; *(float4*)(C + (size_t)row * ldc + col) = o; }
  }
};

struct AttnState { f32x16 o[2]; float m, l; };
DI void attn_init(AttnState& st) {
#pragma unroll
  for (int i = 0; i < 16; i++) { st.o[0][i] = 0.f; st.o[1][i] = 0.f; }
  st.m = -1e30f; st.l = 0.f;
}
template <int KS, int KSTR, int VSTR, bool MASKED, class L>
DI void attn_step(AttnState& st, const bf16x8* qf, const char* Kb, const char* Vb, int lane, L logit) {
  const int r = lane & 31, hh = lane >> 5;
  f32x16 s;
#pragma unroll
  for (int i = 0; i < 16; i++) s[i] = 0.f;
#pragma unroll
  for (int ks = 0; ks < KS; ks++) {
    const bf16x8 a = *(const bf16x8*)(Kb + r * KSTR + (ks * 16 + hh * 8) * 2);
    s = MFMA32(a, qf[ks], s);
  }
  float mx = -1e30f;
  bool vld[16];
#pragma unroll
  for (int i = 0; i < 16; i++) {
    bool v = true;
    const float val = logit(i, s[i], v);
    if (MASKED) { vld[i] = v; s[i] = val; if (v) mx = fmaxf(mx, val); }
    else { s[i] = val; mx = fmaxf(mx, val); }
  }
  mx = fmaxf(mx, __shfl_xor(mx, 32));
  const float mnew = fmaxf(st.m, mx);
  const float alpha = __builtin_amdgcn_exp2f(st.m - mnew);
  float ps = 0.f;
#pragma unroll
  for (int i = 0; i < 16; i++) {
    float p = __builtin_amdgcn_exp2f(s[i] - mnew);
    if (MASKED) p = vld[i] ? p : 0.f;
    s[i] = p; ps += p;
  }
  st.l = st.l * alpha + ps;
  st.m = mnew;
  if (__any(alpha != 1.f)) {
#pragma unroll
    for (int i = 0; i < 16; i++) { st.o[0][i] *= alpha; st.o[1][i] *= alpha; }
  }
  bf16x8 pf[2];
#pragma unroll
  for (int s2 = 0; s2 < 2; s2++) {
    union { bf16x8 v; unsigned u[4]; } pk;
#pragma unroll
    for (int j = 0; j < 4; j++) pk.u[j] = pack2(s[8 * s2 + 2 * j], s[8 * s2 + 2 * j + 1]);
    pf[s2] = pk.v;
  }
  const int i16 = lane & 15, q = i16 >> 2, p4 = i16 & 3, rhalf = (lane >> 4) & 1;
#pragma unroll
  for (int s2 = 0; s2 < 2; s2++) {
#pragma unroll
    for (int blk = 0; blk < 2; blk++) {
      const char* a0 = Vb + (16 * s2 + 4 * hh + q) * VSTR + (blk * 32 + rhalf * 16 + 4 * p4) * 2;
      const s16x4 lo = __builtin_amdgcn_ds_read_tr16_b64_v4i16((s16x4 __attribute__((address_space(3)))*)(a0));
      const s16x4 hi = __builtin_amdgcn_ds_read_tr16_b64_v4i16((s16x4 __attribute__((address_space(3)))*)(a0 + 8 * VSTR));
      const bf16x8 vf = __builtin_shufflevector(lo, hi, 0, 1, 2, 3, 4, 5, 6, 7);
      st.o[blk] = MFMA32(vf, pf[s2], st.o[blk]);
    }
  }
}
template <int KS, int KSTR, int VSTR>
DI void attn_step_raw(AttnState& st, const bf16x8* qf, const char* Kb, const char* Vb, int lane, float sc) {
  const int r = lane & 31, hh = lane >> 5;
  f32x16 s;
#pragma unroll
  for (int i = 0; i < 16; i++) s[i] = 0.f;
#pragma unroll
  for (int ks = 0; ks < KS; ks++) {
    const bf16x8 a = *(const bf16x8*)(Kb + r * KSTR + (ks * 16 + hh * 8) * 2);
    s = MFMA32(a, qf[ks], s);
  }
  float mx = s[0];
#pragma unroll
  for (int i = 1; i < 16; i++) mx = fmaxf(mx, s[i]);
  mx = fmaxf(mx, __shfl_xor(mx, 32));
  const float mnew = fmaxf(st.m, mx * sc);
  const float alpha = __builtin_amdgcn_exp2f(st.m - mnew);
  float ps = 0.f;
#pragma unroll
  for (int i = 0; i < 16; i++) { const float p = __builtin_amdgcn_exp2f(__builtin_fmaf(s[i], sc, -mnew)); s[i] = p; ps += p; }
  st.l = st.l * alpha + ps;
  st.m = mnew;
  if (__any(alpha != 1.f)) {
#pragma unroll
    for (int i = 0; i < 16; i++) { st.o[0][i] *= alpha; st.o[1][i] *= alpha; }
  }
  bf16x8 pf[2];
#pragma unroll
  for (int s2 = 0; s2 < 2; s2++) {
    union { bf16x8 v; unsigned u[4]; } pk;
#pragma unroll
    for (int j = 0; j < 4; j++) pk.u[j] = pack2(s[8 * s2 + 2 * j], s[8 * s2 + 2 * j + 1]);
    pf[s2] = pk.v;
  }
  const int i16 = lane & 15, q = i16 >> 2, p4 = i16 & 3, rhalf = (lane >> 4) & 1;
#pragma unroll
  for (int s2 = 0; s2 < 2; s2++) {
#pragma unroll
    for (int blk = 0; blk < 2; blk++) {
      const char* a0 = Vb + (16 * s2 + 4 * hh + q) * VSTR + (blk * 32 + rhalf * 16 + 4 * p4) * 2;
      const s16x4 lo = __builtin_amdgcn_ds_read_tr16_b64_v4i16((s16x4 __attribute__((address_space(3)))*)(a0));
      const s16x4 hi = __builtin_amdgcn_ds_read_tr16_b64_v4i16((s16x4 __attribute__((address_space(3)))*)(a0 + 8 * VSTR));
      const bf16x8 vf = __builtin_shufflevector(lo, hi, 0, 1, 2, 3, 4, 5, 6, 7);
      st.o[blk] = MFMA32(vf, pf[s2], st.o[blk]);
    }
  }
}
template <int KS, int KSTR, int VSTR>
DI void attn_step_raw2(AttnState& sa, AttnState& sb, const bf16x8* qfa, const bf16x8* qfb, const char* Kb, const char* Vb, int lane, float sc) {
  const int r = lane & 31, hh = lane >> 5;
  f32x16 xa, xb;
#pragma unroll
  for (int i = 0; i < 16; i++) { xa[i] = 0.f; xb[i] = 0.f; }
#pragma unroll
  for (int ks = 0; ks < KS; ks++) {
    const bf16x8 a = *(const bf16x8*)(Kb + r * KSTR + (ks * 16 + hh * 8) * 2);
    xa = MFMA32(a, qfa[ks], xa);
    xb = MFMA32(a, qfb[ks], xb);
  }
  float ma = xa[0], mb = xb[0];
#pragma unroll
  for (int i = 1; i < 16; i++) { ma = fmaxf(ma, xa[i]); mb = fmaxf(mb, xb[i]); }
  ma = fmaxf(ma, __shfl_xor(ma, 32)); mb = fmaxf(mb, __shfl_xor(mb, 32));
  const float na = fmaxf(sa.m, ma * sc), nb = fmaxf(sb.m, mb * sc);
  const float aa = __builtin_amdgcn_exp2f(sa.m - na), ab = __builtin_amdgcn_exp2f(sb.m - nb);
  float pa = 0.f, pb = 0.f;
#pragma unroll
  for (int i = 0; i < 16; i++) {
    const float u = __builtin_amdgcn_exp2f(__builtin_fmaf(xa[i], sc, -na)); xa[i] = u; pa += u;
    const float v = __builtin_amdgcn_exp2f(__builtin_fmaf(xb[i], sc, -nb)); xb[i] = v; pb += v;
  }
  sa.l = sa.l * aa + pa; sa.m = na;
  sb.l = sb.l * ab + pb; sb.m = nb;
  if (__any(aa != 1.f)) {
#pragma unroll
    for (int i = 0; i < 16; i++) { sa.o[0][i] *= aa; sa.o[1][i] *= aa; }
  }
  if (__any(ab != 1.f)) {
#pragma unroll
    for (int i = 0; i < 16; i++) { sb.o[0][i] *= ab; sb.o[1][i] *= ab; }
  }
  bf16x8 pfa[2], pfb[2];
#pragma unroll
  for (int s2 = 0; s2 < 2; s2++) {
    union { bf16x8 v; unsigned u[4]; } ka, kb;
#pragma unroll
    for (int j = 0; j < 4; j++) { ka.u[j] = pack2(xa[8 * s2 + 2 * j], xa[8 * s2 + 2 * j + 1]); kb.u[j] = pack2(xb[8 * s2 + 2 * j], xb[8 * s2 + 2 * j + 1]); }
    pfa[s2] = ka.v; pfb[s2] = kb.v;
  }
  const int i16 = lane & 15, q = i16 >> 2, p4 = i16 & 3, rhalf = (lane >> 4) & 1;
#pragma unroll
  for (int s2 = 0; s2 < 2; s2++) {
#pragma unroll
    for (int blk = 0; blk < 2; blk++) {
      const char* a0 = Vb + (16 * s2 + 4 * hh + q) * VSTR + (blk * 32 + rhalf * 16 + 4 * p4) * 2;
      const s16x4 lo = __builtin_amdgcn_ds_read_tr16_b64_v4i16((s16x4 __attribute__((address_space(3)))*)(a0));
      const s16x4 hi = __builtin_amdgcn_ds_read_tr16_b64_v4i16((s16x4 __attribute__((address_space(3)))*)(a0 + 8 * VSTR));
      const bf16x8 vf = __builtin_shufflevector(lo, hi, 0, 1, 2, 3, 4, 5, 6, 7);
      sa.o[blk] = MFMA32(vf, pfa[s2], sa.o[blk]);
      sb.o[blk] = MFMA32(vf, pfb[s2], sb.o[blk]);
    }
  }
}
DI void attn_final(AttnState& st, float& inv_l, float& lse) {
  const float lt = st.l + __shfl_xor(st.l, 32);
  inv_l = 1.f / lt;
  lse = st.m * 0.6931471805599453f + __logf(lt);
}
DI void attn_store(const AttnState& st, u16* dstrow, float sc, int hh) {
#pragma unroll
  for (int blk = 0; blk < 2; blk++)
#pragma unroll
    for (int g = 0; g < 4; g++) {
      uint2 o;
      o.x = pack2(st.o[blk][4 * g] * sc, st.o[blk][4 * g + 1] * sc);
      o.y = pack2(st.o[blk][4 * g + 2] * sc, st.o[blk][4 * g + 3] * sc);
      *(uint2*)(dstrow + blk * 32 + 8 * g + 4 * hh) = o;
    }
}

DI int rel_bucket(int n) {
  if (n < 16) return n;
  const float nf = (float)n;
  int large = 16 + (int)(logf(nf / 16.f) / 4.852030263919617f * 16.f);
  return large < 31 ? large : 31;
}

DI void band_tile(const u16* Q, const u16* Kc, const u16* Vc, size_t rs, bool has_prev, int dil, int max_dist,
                  const float* rel_bias, int head, u16* O, size_t ors, float* lse_out, size_t lse_stride,
                  bool use_sink, float sink, char* smem) {
  const int tid = TIDX(), lane = tid & 63, w = tid >> 6, r = lane & 31, hh = lane >> 5;
  char* Ks = smem; char* Vs = smem + 256 * 144; float* biasd = (float*)(smem + 2 * 256 * 144);
#pragma unroll
  for (int i = 0; i < 8; i++) {
    const int c = tid + 256 * i, row = c >> 3, ch = c & 7;
    if (row >= 128 || has_prev) {
      const ptrdiff_t off = (ptrdiff_t)(row - 128) * (ptrdiff_t)rs + ch * 8;
      *(u32x4*)(Ks + row * 144 + ch * 16) = *(const u32x4*)(Kc + off);
      *(u32x4*)(Vs + row * 144 + ch * 16) = *(const u32x4*)(Vc + off);
    }
  }
  if (tid < 129) biasd[tid] = rel_bias[rel_bucket(tid * dil) * 16 + head] * 1.4426950408889634f;
  bf16x8 qf[4];
  const u16* qrow = Q + (size_t)(32 * w + r) * rs;
#pragma unroll
  for (int ks = 0; ks < 4; ks++) qf[ks] = *(const bf16x8*)(qrow + ks * 16 + hh * 8);
  __syncthreads();
  AttnState st; attn_init(st);
  const int qi = 32 * w + r;
  for (int kt = 0; kt < 5; kt++) {
    const int kwin = 32 * (w + kt);
    if (!has_prev && kwin < 128) continue;
    if (kt == 0 || kt == 4) {
      attn_step<4, 144, 144, true>(st, qf, Ks + kwin * 144, Vs + kwin * 144, lane,
        [&](int i, float raw, bool& v) -> float {
          const int kj = kwin + crow(i, hh);
          const int dist = 128 + qi - kj;
          v = (dist >= 0) && (dist <= max_dist);
          const int dc = dist < 0 ? 0 : (dist > 128 ? 128 : dist);
          return raw * (0.125f * 1.4426950408889634f) + biasd[dc];
        });
    } else {
      attn_step<4, 144, 144, false>(st, qf, Ks + kwin * 144, Vs + kwin * 144, lane,
        [&](int i, float raw, bool& v) -> float {
          const int dist = 128 + qi - (kwin + crow(i, hh));
          return raw * (0.125f * 1.4426950408889634f) + biasd[dist];
        });
    }
  }
  float inv_l, lse; attn_final(st, inv_l, lse);
  float sc = inv_l;
  if (use_sink) sc *= 1.f / (1.f + __expf(-(lse - sink)));
  attn_store(st, O + (size_t)qi * ors, sc, hh);
  if (lse_out && hh == 0) lse_out[(size_t)qi * lse_stride] = lse;
  __syncthreads();
}

DI void phase_prep(const Params& p, char* smem) {
  char* ws = p.ws;
  for (int j = 0; j < 2; j++) {
    transpose_convert(p.swa_w_in + (size_t)j * 1024 * 1280, (u16*)(ws + OFF_WT_SWA_IN) + (size_t)j * 1280 * LDW, 1024, 1280, LDW, smem);
    transpose_convert(p.swa_w_out + (size_t)j * 1024 * 1024, (u16*)(ws + OFF_WT_SWA_OUT) + (size_t)j * 1024 * LDW, 1024, 1024, LDW, smem);
  }
  transpose_convert(p.dil_w_in, (u16*)(ws + OFF_WT_DIL_IN), 1024, 9216, LDW, smem);
  transpose_convert(p.dil_w_out, (u16*)(ws + OFF_WT_DIL_OUT), 1024, 1024, LDW, smem);
  transpose_convert(p.mla_w_in, (u16*)(ws + OFF_WT_MLA_IN), 1024, 416, LDW, smem);
  transpose_convert(p.mla_w_uq, (u16*)(ws + OFF_WT_MLA_UQ), 256, 1536, 256, smem);
  transpose_convert(p.mla_w_ukv, (u16*)(ws + OFF_WT_MLA_UKV), 128, 2048, 128, smem);
  transpose_convert(p.mla_w_out, (u16*)(ws + OFF_WT_MLA_OUT), 1024, 1024, LDW, smem);
  for (int j = 0; j < 4; j++)
    transpose_convert(p.peer_w_q + (size_t)j * 1024 * 2048, (u16*)(ws + OFF_WT_PEER_Q) + (size_t)j * 2048 * LDW, 1024, 2048, LDW, smem);
  {
    uint4* z = (uint4*)((u16*)(ws + OFF_WT_MLA_IN) + 416ull * LDW);
    const size_t n = 96ull * LDW * 2 / 16;
    for (size_t i = (size_t)blockIdx.x * NT + TIDX(); i < n; i += (size_t)gridDim.x * NT) z[i] = make_uint4(0, 0, 0, 0);
  }
  convert_f32_bf16(p.peer_keys, (u16*)(ws + OFF_KEYS), 4ull * 8 * 2 * 128 * 128);
  convert_rows_bf16(p.x, (u16*)(ws + OFF_XB), T_TOK, LDX);
}

DI void phase_inproj(const Params& p, int L, char* smem) {
  char* ws = p.ws;
  const int kind = L % 3, j = L / 3;
  const u16* XB = (const u16*)(ws + OFF_XB);
  if (kind == 0) {
    EpiBf16 e{(u16*)(ws + OFF_BIG), LD_SWA, 1280};
    gemm_phase(XB, LDX, (const u16*)(ws + OFF_WT_SWA_IN) + (size_t)j * 1280 * LDW, LDW, T_TOK, 1280, 1024, smem, e);
  } else if (kind == 1) {
    EpiBf16 e{(u16*)(ws + OFF_BIG), LD_DIL, 9216};
    gemm_phase(XB, LDX, (const u16*)(ws + OFF_WT_DIL_IN), LDW, T_TOK, 9216, 1024, smem, e);
  } else {
    EpiF32 e{(float*)(ws + OFF_BIG + BIG_CF), 416, 416};
    gemm_phase(XB, LDX, (const u16*)(ws + OFF_WT_MLA_IN), LDW, T_TOK, 512, 1024, smem, e);
  }
  convert_rows_fp4(p.peer_u + (size_t)L * 16384 * 1024, (unsigned char*)(ws + OFF_UB), (float*)(ws + OFF_SU), 16384);
  convert_rows_fp4(p.peer_v + (size_t)L * 16384 * 1024, (unsigned char*)(ws + OFF_VB), (float*)(ws + OFF_SV), 16384);
}

DI void phase_mla_norm(const Params& p, char* smem) {
  char* ws = p.ws;
  const float* CF = (const float*)(ws + OFF_BIG + BIG_CF);
  u16* CQ = (u16*)(ws + OFF_BIG + BIG_CQ); u16* CKV = (u16*)(ws + OFF_BIG + BIG_CKV); u16* KR = (u16*)(ws + OFF_BIG + BIG_KR);
  const int lane = TIDX() & 63, wave = TIDX() >> 6;
  for (int t = blockIdx.x * 4 + wave; t < T_TOK; t += gridDim.x * 4) {
    const float* c = CF + (size_t)t * 416;
    const float4 cq = *(const float4*)(c + lane * 4);
    const float2 ckv = *(const float2*)(c + 256 + lane * 2);
    float sq = cq.x * cq.x + cq.y * cq.y + cq.z * cq.z + cq.w * cq.w;
    float skv = ckv.x * ckv.x + ckv.y * ckv.y;
    sq = wave_sum(sq); skv = wave_sum(skv);
    const float rq = rsqrtf(sq * (1.f / 256.f) + 1e-6f), rkv = rsqrtf(skv * (1.f / 128.f) + 1e-6f);
    const float4 gq = *(const float4*)(p.mla_q_norm + lane * 4);
    const float2 gkv = *(const float2*)(p.mla_kv_norm + lane * 2);
    uint2 oq; oq.x = pack2(cq.x * rq * gq.x, cq.y * rq * gq.y); oq.y = pack2(cq.z * rq * gq.z, cq.w * rq * gq.w);
    *(uint2*)(CQ + (size_t)t * 256 + lane * 4) = oq;
    *(unsigned*)(CKV + (size_t)t * 128 + lane * 2) = pack2(ckv.x * rkv * gkv.x, ckv.y * rkv * gkv.y);
    if (lane < 16) {
      const float t1 = c[384 + lane], t2 = c[384 + 16 + lane];
      const float freq = powf(10000.f, -(float)lane / 16.f);
      const float ang = (float)(t % SEQ) * freq;
      float sn, cs; sincosf(ang, &sn, &cs);
      KR[(size_t)t * 32 + lane] = f2bf(t1 * cs - t2 * sn);
      KR[(size_t)t * 32 + 16 + lane] = f2bf(t1 * sn + t2 * cs);
    }
  }
}
DI void phase_mla_up(const Params& p, char* smem) {
  char* ws = p.ws;
  EpiBf16 e1{(u16*)(ws + OFF_BIG + BIG_QM), LD_QM, 1536};
  gemm_phase((const u16*)(ws + OFF_BIG + BIG_CQ), 256, (const u16*)(ws + OFF_WT_MLA_UQ), 256, T_TOK, 1536, 256, smem, e1);
  EpiBf16 e2{(u16*)(ws + OFF_BIG + BIG_KVM), LD_KVM, 2048};
  gemm_phase((const u16*)(ws + OFF_BIG + BIG_CKV), 128, (const u16*)(ws + OFF_WT_MLA_UKV), 128, T_TOK, 2048, 128, smem, e2);
}
DI void phase_mla_ropeq(const Params& p) {
  u16* QM = (u16*)(p.ws + OFF_BIG + BIG_QM);
  const size_t n = (size_t)T_TOK * 16 * 16;
  for (size_t i = (size_t)blockIdx.x * NT + TIDX(); i < n; i += (size_t)gridDim.x * NT) {
    const int jj = (int)(i & 15), h = (int)((i >> 4) & 15); const size_t t = i >> 8;
    u16* q = QM + t * LD_QM + h * 96 + 64;
    const float t1 = bf2f(q[jj]), t2 = bf2f(q[16 + jj]);
    const float freq = powf(10000.f, -(float)jj / 16.f);
    const float ang = (float)(t % SEQ) * freq;
    float sn, cs; sincosf(ang, &sn, &cs);
    q[jj] = f2bf(t1 * cs - t2 * sn);
    q[16 + jj] = f2bf(t1 * sn + t2 * cs);
  }
}

DI void phase_attn_swa(const Params& p, int j, char* smem) {
  char* ws = p.ws;
  const u16* QKV = (const u16*)(ws + OFF_BIG);
  u16* AO = (u16*)(ws + OFF_AO);
  const int tid = TIDX(), lane = tid & 63, w = tid >> 6, r = lane & 31, hh = lane >> 5;
  char* Ks = smem; char* Vs = smem + 256 * 144; float* biasd = (float*)(smem + 2 * 256 * 144);
  const int total = 4 * 2 * 64;
  for (int t = blockIdx.x; t < total; t += gridDim.x) {
    const int n = t & 63, kvh = (t >> 6) & 1, b = t >> 7;
    const bool has_prev = n > 0;
    const size_t tok0 = (size_t)b * SEQ + (size_t)n * 128;
    const u16* Kc = QKV + tok0 * 1280 + 1024 + kvh * 64;
    const u16* Vc = QKV + tok0 * 1280 + 1152 + kvh * 64;
#pragma unroll
    for (int i = 0; i < 8; i++) {
      const int c = tid + 256 * i, row = c >> 3, ch = c & 7;
      if (row >= 128 || has_prev) {
        const ptrdiff_t off = (ptrdiff_t)(row - 128) * 1280 + ch * 8;
        *(u32x4*)(Ks + row * 144 + ch * 16) = *(const u32x4*)(Kc + off);
        *(u32x4*)(Vs + row * 144 + ch * 16) = *(const u32x4*)(Vc + off);
      }
    }
#pragma unroll
    for (int i = 0; i < 4; i++) {
      const int e = tid + 256 * i, g = e >> 7, d = e & 127;
      biasd[e] = p.rel_bias[rel_bucket(d) * 16 + kvh * 8 + g] * 1.4426950408889634f;
    }
    __syncthreads();
    const int qi = 32 * w + r;
    for (int g = 0; g < 8; g++) {
      const int h = kvh * 8 + g;
      const float* bd = biasd + g * 128;
      bf16x8 qf[4];
      const u16* qrow = QKV + (tok0 + qi) * 1280 + h * 64;
#pragma unroll
      for (int ks = 0; ks < 4; ks++) qf[ks] = *(const bf16x8*)(qrow + ks * 16 + hh * 8);
      AttnState st; attn_init(st);
      for (int kt = 0; kt < 5; kt++) {
        const int kwin = 32 * (w + kt);
        if (!has_prev && kwin < 128) continue;
        if (kt == 0 || kt == 4) {
          attn_step<4, 144, 144, true>(st, qf, Ks + kwin * 144, Vs + kwin * 144, lane,
            [&](int i, float raw, bool& v) -> float {
              const int dist = 128 + qi - (kwin + crow(i, hh));
              v = (dist >= 0) && (dist <= 127);
              const int dc = dist < 0 ? 0 : (dist > 127 ? 127 : dist);
              return raw * (0.125f * 1.4426950408889634f) + bd[dc];
            });
        } else {
          attn_step<4, 144, 144, false>(st, qf, Ks + kwin * 144, Vs + kwin * 144, lane,
            [&](int i, float raw, bool& v) -> float {
              const int dist = 128 + qi - (kwin + crow(i, hh));
              return raw * (0.125f * 1.4426950408889634f) + bd[dist];
            });
        }
      }
      float inv_l, lse; attn_final(st, inv_l, lse);
      const float sc = inv_l / (1.f + __expf(-(lse - p.swa_sinks[j * 16 + h])));
      attn_store(st, AO + (tok0 + qi) * LDX + h * 64, sc, hh);
    }
    __syncthreads();
  }
}
DI void phase_attn_dil(const Params& p, char* smem) {
  char* ws = p.ws;
  u16* QKV = (u16*)(ws + OFF_BIG);
  float* LSE = (float*)(ws + OFF_LSE);
  const int total = 3 * 4096;
  for (int t = blockIdx.x; t < total; t += gridDim.x) {
    const int g = t >> 12; const int u = t & 4095;
    const int dil = (g == 0) ? 1 : (g == 1 ? 4 : 16);
    const int nb = 64 / dil;
    const int n = u % nb; int v = u / nb;
    const int h = v & 15; v >>= 4;
    const int rr = v % dil, b = v / dil;
    const size_t tok0 = (size_t)b * SEQ + (size_t)(n * 128) * dil + rr;
    const size_t rs = (size_t)dil * LD_DIL;
    u16* Q = QKV + tok0 * LD_DIL + (size_t)(g * 3) * 1024 + h * 64;
    const u16* Kc = QKV + tok0 * LD_DIL + (size_t)(g * 3 + 1) * 1024 + h * 64;
    const u16* Vc = QKV + tok0 * LD_DIL + (size_t)(g * 3 + 2) * 1024 + h * 64;
    band_tile(Q, Kc, Vc, rs, n > 0, dil, 128, p.rel_bias, h, Q, rs, LSE + ((size_t)g * T_TOK + tok0) * 16 + h, (size_t)dil * 16,
              false, 0.f, smem);
  }
}
DI void phase_dil_mix(const Params& p) {
  char* ws = p.ws;
  const u16* QKV = (const u16*)(ws + OFF_BIG);
  const float* LSE = (const float*)(ws + OFF_LSE);
  u16* AO = (u16*)(ws + OFF_AO);
  const size_t n = (size_t)T_TOK * 16 * 8;
  for (size_t i = (size_t)blockIdx.x * NT + TIDX(); i < n; i += (size_t)gridDim.x * NT) {
    const int c = (int)(i & 7), h = (int)((i >> 3) & 15); const size_t t = i >> 7;
    const float l0 = LSE[(0 * (size_t)T_TOK + t) * 16 + h], l1 = LSE[(1 * (size_t)T_TOK + t) * 16 + h], l2 = LSE[(2 * (size_t)T_TOK + t) * 16 + h];
    const float mx = fmaxf(l0, fmaxf(l1, l2));
    float w0 = __expf(l0 - mx), w1 = __expf(l1 - mx), w2 = __expf(l2 - mx);
    const float inv = 1.f / (w0 + w1 + w2); w0 *= inv; w1 *= inv; w2 *= inv;
    const uint4 a = *(const uint4*)(QKV + t * LD_DIL + 0 * 1024 + h * 64 + c * 8);
    const uint4 b = *(const uint4*)(QKV + t * LD_DIL + 3 * 1024 + h * 64 + c * 8);
    const uint4 d = *(const uint4*)(QKV + t * LD_DIL + 6 * 1024 + h * 64 + c * 8);
    uint4 o;
    o.x = pack2(w0 * bflo(a.x) + w1 * bflo(b.x) + w2 * bflo(d.x), w0 * bfhi(a.x) + w1 * bfhi(b.x) + w2 * bfhi(d.x));
    o.y = pack2(w0 * bflo(a.y) + w1 * bflo(b.y) + w2 * bflo(d.y), w0 * bfhi(a.y) + w1 * bfhi(b.y) + w2 * bfhi(d.y));
    o.z = pack2(w0 * bflo(a.z) + w1 * bflo(b.z) + w2 * bflo(d.z), w0 * bfhi(a.z) + w1 * bfhi(b.z) + w2 * bfhi(d.z));
    o.w = pack2(w0 * bflo(a.w) + w1 * bflo(b.w) + w2 * bflo(d.w), w0 * bfhi(a.w) + w1 * bfhi(b.w) + w2 * bfhi(d.w));
    *(uint4*)(AO + t * LDX + h * 64 + c * 8) = o;
  }
}

DI void phase_attn_mla(const Params& p, char* smem) {
  char* ws = p.ws;
  const u16* QM = (const u16*)(ws + OFF_BIG + BIG_QM);
  const u16* KVM = (const u16*)(ws + OFF_BIG + BIG_KVM);
  const u16* KR = (const u16*)(ws + OFF_BIG + BIG_KR);
  u16* AO = (u16*)(ws + OFF_AO);
  const int tid = TIDX(), lane = tid & 63, w = tid >> 6, r = lane & 31, hh = lane >> 5;
  constexpr int KSTR = 208, VSTR = 144;
  char* Ks = smem; char* Vs = smem + 64 * KSTR;
  const int total = 2048; const int G = gridDim.x;
  const float scale = 0.10206207261596575f * 1.4426950408889634f;
  for (int k = 0; k * G < total; k++) {
    const int item = (k & 1) ? (k * G + (G - 1 - (int)blockIdx.x)) : (k * G + (int)blockIdx.x);
    if (item >= total) continue;
    const int n = 31 - (item >> 6); const int bh = item & 63; const int b = bh >> 4, h = bh & 15;
    const size_t tokb = (size_t)b * SEQ;
    const int qmin0 = n * 256 + 64 * w;
    bf16x8* qfa = (bf16x8*)(smem + 64 * KSTR + 64 * VSTR) + ((w * 2 + 0) * 64 + lane) * 6;
    bf16x8* qfb = (bf16x8*)(smem + 64 * KSTR + 64 * VSTR) + ((w * 2 + 1) * 64 + lane) * 6;
    {
      const u16* qrow = QM + (tokb + qmin0 + r) * LD_QM + h * 96;
#pragma unroll
      for (int ks = 0; ks < 4; ks++) { qfa[ks] = *(const bf16x8*)(qrow + ks * 16 + hh * 8); qfb[ks] = *(const bf16x8*)(qrow + 32 * LD_QM + ks * 16 + hh * 8); }
#pragma unroll
      for (int sb = 0; sb < 2; sb++) {
        const u16* qr = qrow + sb * 32 * LD_QM;
        union { bf16x8 v; unsigned u[4]; } t1, t2, o1, o2;
        t1.v = *(const bf16x8*)(qr + 64 + hh * 8); t2.v = *(const bf16x8*)(qr + 80 + hh * 8);
        const float pos = (float)(qmin0 + sb * 32 + r);
#pragma unroll
        for (int jp = 0; jp < 4; jp++) {
          float r1[2], r2[2];
#pragma unroll
          for (int e = 0; e < 2; e++) {
            const int jr = 8 * hh + 2 * jp + e;
            const float a1 = e ? bfhi(t1.u[jp]) : bflo(t1.u[jp]);
            const float a2 = e ? bfhi(t2.u[jp]) : bflo(t2.u[jp]);
            const float freq = powf(10000.f, -(float)jr / 16.f);
            float sn, cs; sincosf(pos * freq, &sn, &cs);
            r1[e] = a1 * cs - a2 * sn; r2[e] = a1 * sn + a2 * cs;
          }
          o1.u[jp] = pack2(r1[0], r1[1]); o2.u[jp] = pack2(r2[0], r2[1]);
        }
        if (sb == 0) { qfa[4] = o1.v; qfa[5] = o2.v; } else { qfb[4] = o1.v; qfb[5] = o2.v; }
      }
    }
    AttnState sta, stb; attn_init(sta); attn_init(stb);
    const int ntiles = 4 * n + 4;
    u32x4 rk[3], rv[2];
    auto gload = [&](int kt) {
      const size_t kb = tokb + (size_t)kt * 64;
#pragma unroll
      for (int i = 0; i < 3; i++) {
        const int c = tid + 256 * i, row = c / 12, ch = c % 12;
        rk[i] = (ch < 8) ? *(const u32x4*)(KVM + (kb + row) * LD_KVM + h * 128 + ch * 8)
                         : *(const u32x4*)(KR + (kb + row) * 32 + (ch - 8) * 8);
      }
#pragma unroll
      for (int i = 0; i < 2; i++) {
        const int c = tid + 256 * i, row = c >> 3, ch = c & 7;
        rv[i] = *(const u32x4*)(KVM + (kb + row) * LD_KVM + h * 128 + 64 + ch * 8);
      }
    };
    gload(0);
    for (int kt = 0; kt < ntiles; kt++) {
#pragma unroll
      for (int i = 0; i < 3; i++) { const int c = tid + 256 * i, row = c / 12, ch = c % 12; *(u32x4*)(Ks + row * KSTR + ch * 16) = rk[i]; }
#pragma unroll
      for (int i = 0; i < 2; i++) { const int c = tid + 256 * i, row = c >> 3, ch = c & 7; *(u32x4*)(Vs + row * VSTR + ch * 16) = rv[i]; }
      __syncthreads();
      if (kt + 1 < ntiles) gload(kt + 1);
#pragma unroll
      for (int sub = 0; sub < 2; sub++) {
        const int kb0 = kt * 64 + sub * 32;
        if (kb0 + 31 <= qmin0) {
          attn_step_raw2<6, KSTR, VSTR>(sta, stb, qfa, qfb, Ks + sub * 32 * KSTR, Vs + sub * 32 * VSTR, lane, scale);
          continue;
        }
        if (kb0 <= qmin0 + 31) {
          if (kb0 + 31 > qmin0) {
            const int qpos = qmin0 + r;
            attn_step<6, KSTR, VSTR, true>(sta, qfa, Ks + sub * 32 * KSTR, Vs + sub * 32 * VSTR, lane,
              [&](int i, float raw, bool& v) -> float { v = (kb0 + crow(i, hh)) <= qpos; return raw * scale; });
          } else {
            attn_step_raw<6, KSTR, VSTR>(sta, qfa, Ks + sub * 32 * KSTR, Vs + sub * 32 * VSTR, lane, scale);
          }
        }
        if (kb0 <= qmin0 + 63) {
          if (kb0 + 31 > qmin0 + 32) {
            const int qpos = qmin0 + 32 + r;
            attn_step<6, KSTR, VSTR, true>(stb, qfb, Ks + sub * 32 * KSTR, Vs + sub * 32 * VSTR, lane,
              [&](int i, float raw, bool& v) -> float { v = (kb0 + crow(i, hh)) <= qpos; return raw * scale; });
          } else {
            attn_step_raw<6, KSTR, VSTR>(stb, qfb, Ks + sub * 32 * KSTR, Vs + sub * 32 * VSTR, lane, scale);
          }
        }
      }
      __syncthreads();
    }
    float inv_l, lse;
    attn_final(sta, inv_l, lse);
    attn_store(sta, AO + (tokb + qmin0 + r) * LDX + h * 64, inv_l, hh);
    attn_final(stb, inv_l, lse);
    attn_store(stb, AO + (tokb + qmin0 + 32 + r) * LDX + h * 64, inv_l, hh);
  }
}

DI void phase_outproj(const Params& p, int L, char* smem) {
  char* ws = p.ws;
  const int kind = L % 3, j = L / 3;
  const u16* W = (kind == 0) ? (const u16*)(ws + OFF_WT_SWA_OUT) + (size_t)j * 1024 * LDW
               : (kind == 1) ? (const u16*)(ws + OFF_WT_DIL_OUT) : (const u16*)(ws + OFF_WT_MLA_OUT);
  EpiBf16 e{(u16*)(ws + OFF_BIG + BIG_Y), LD_Y, 1024};
  gemm_phase((const u16*)(ws + OFF_AO), LDX, W, LDW, T_TOK, 1024, 1024, smem, e);
}

DI void ln_row_store(const float* v, const float* g, const float* bta, int lane, float* outf, u16* outb) {
  float s = 0.f;
#pragma unroll
  for (int i = 0; i < 16; i++) s += v[i];
  const float mu = wave_sum(s) * (1.f / 1024.f);
  float q = 0.f;
#pragma unroll
  for (int i = 0; i < 16; i++) { const float d = v[i] - mu; q += d * d; }
  const float var = wave_sum(q) * (1.f / 1024.f);
  const float rstd = rsqrtf(var + 1e-5f);
#pragma unroll
  for (int half = 0; half < 2; half++) {
    const int c0 = half * 512 + lane * 8;
    const float4 g0 = *(const float4*)(g + c0), g1 = *(const float4*)(g + c0 + 4);
    const float4 b0 = *(const float4*)(bta + c0), b1 = *(const float4*)(bta + c0 + 4);
    float o[8];
    const float gg[8] = {g0.x, g0.y, g0.z, g0.w, g1.x, g1.y, g1.z, g1.w};
    const float bb[8] = {b0.x, b0.y, b0.z, b0.w, b1.x, b1.y, b1.z, b1.w};
#pragma unroll
    for (int i = 0; i < 8; i++) o[i] = (v[half * 8 + i] - mu) * rstd * gg[i] + bb[i];
    if (outf) {
      *(float4*)(outf + c0) = make_float4(o[0], o[1], o[2], o[3]);
      *(float4*)(outf + c0 + 4) = make_float4(o[4], o[5], o[6], o[7]);
    }
    if (outb) {
      uint4 ob; ob.x = pack2(o[0], o[1]); ob.y = pack2(o[2], o[3]); ob.z = pack2(o[4], o[5]); ob.w = pack2(o[6], o[7]);
      *(uint4*)(outb + c0) = ob;
    }
  }
}
DI void load_row16(const float* src, int lane, float* v) {
#pragma unroll
  for (int half = 0; half < 2; half++) {
    const float4 a = *(const float4*)(src + half * 512 + lane * 8), b = *(const float4*)(src + half * 512 + lane * 8 + 4);
    v[half * 8 + 0] = a.x; v[half * 8 + 1] = a.y; v[half * 8 + 2] = a.z; v[half * 8 + 3] = a.w;
    v[half * 8 + 4] = b.x; v[half * 8 + 5] = b.y; v[half * 8 + 6] = b.z; v[half * 8 + 7] = b.w;
  }
}

DI void load_row16_bf(const u16* src, int lane, float* v) {
#pragma unroll
  for (int half = 0; half < 2; half++) {
    const u32x4 a = *(const u32x4*)(src + half * 512 + lane * 8);
#pragma unroll
    for (int k = 0; k < 4; k++) { v[half * 8 + 2 * k] = bflo(a[k]); v[half * 8 + 2 * k + 1] = bfhi(a[k]); }
  }
}

DI void phase_ln1(const Params& p, int L) {
  char* ws = p.ws;
  const u16* Y = (const u16*)(ws + OFF_BIG + BIG_Y);
  u16* XB = (u16*)(ws + OFF_XB);
  const float* g = p.ln_g + (size_t)(L * 2 + 0) * 1024; const float* bt = p.ln_b + (size_t)(L * 2 + 0) * 1024;
  const int lane = TIDX() & 63, wave = TIDX() >> 6;
  for (int t = blockIdx.x * 4 + wave; t < T_TOK; t += gridDim.x * 4) {
    float xv[16], yv[16];
    if (L == 0) load_row16(p.x + (size_t)t * 1024, lane, xv);
    else load_row16_bf(XB + (size_t)t * LDX, lane, xv);
    load_row16_bf(Y + (size_t)t * LD_Y, lane, yv);
#pragma unroll
    for (int i = 0; i < 16; i++) xv[i] = DN_ALPHA * xv[i] + yv[i];
    ln_row_store(xv, g, bt, lane, nullptr, XB + (size_t)t * LDX);
  }
}

DI void phase_peer_q(const Params& p, int L, char* smem) {
  char* ws = p.ws;
  EpiBf16 e{(u16*)(ws + OFF_BIG + BIG_PQ), LD_PQ, 2048};
  gemm_phase((const u16*)(ws + OFF_XB), LDX, (const u16*)(ws + OFF_WT_PEER_Q) + (size_t)L * 2048 * LDW, LDW, T_TOK, 2048, 1024, smem, e);
}

DI unsigned f2ord(float f) { const unsigned u = __float_as_uint(f); return (u & 0x80000000u) ? ~u : (u | 0x80000000u); }
DI float ord2f(unsigned o) { const unsigned u = (o & 0x80000000u) ? (o & 0x7fffffffu) : ~o; return __uint_as_float(u); }
DI void topk_insert(unsigned (&Lst)[16], unsigned x) {
#pragma unroll
  for (int j = 0; j < 16; j++) { const unsigned hi = max(Lst[j], x); x = min(Lst[j], x); Lst[j] = hi; }
}

DI void ce_desc(unsigned& a, unsigned& b) { const unsigned hi = max(a, b), lo = min(a, b); a = hi; b = lo; }
DI void sort16_desc(unsigned (&a)[16]) {
#pragma unroll
  for (int k = 2; k <= 16; k <<= 1)
#pragma unroll
    for (int j = k >> 1; j > 0; j >>= 1)
#pragma unroll
      for (int i = 0; i < 16; i++) {
        const int l = i ^ j;
        if (l > i) { if ((i & k) == 0) ce_desc(a[i], a[l]); else ce_desc(a[l], a[i]); }
      }
}
DI void merge16_desc(unsigned (&Lm)[16], const unsigned (&S)[16]) {
#pragma unroll
  for (int i = 0; i < 16; i++) Lm[i] = max(Lm[i], S[15 - i]);
#pragma unroll
  for (int j = 8; j > 0; j >>= 1)
#pragma unroll
    for (int i = 0; i < 16; i++) if ((i & j) == 0) ce_desc(Lm[i], Lm[i + j]);
}

DI void phase_peer_topk(const Params& p, int L, char* smem) {
  char* ws = p.ws;
  const u16* PQ = (const u16*)(ws + OFF_BIG + BIG_PQ);
  const u16* KEYS = (const u16*)(ws + OFF_KEYS) + (size_t)L * 8 * 2 * 128 * 128;
  int* IDX = (int*)(ws + OFF_BIG + BIG_IDX); float* GATE = (float*)(ws + OFF_BIG + BIG_GATE); float* SUE = (float*)(ws + OFF_BIG + BIG_SUE);
  const float* SU = (const float*)(ws + OFF_SU); const float* SV = (const float*)(ws + OFF_SV);
  const int tid = TIDX(), lane = tid & 63, w = tid >> 6, r = lane & 31, hh = lane >> 5;
  constexpr int SST = 132;
  float* sc = (float*)smem;
  unsigned* fin = (unsigned*)(smem + 2 * 64 * SST * 4);
  const int total = (T_TOK / 64) * 8;
  for (int t = blockIdx.x; t < total; t += gridDim.x) {
    const int h = t & 7, tt = t >> 3; const size_t tok0 = (size_t)tt * 64;
    {
      const int pp = w & 1, tb = w >> 1;
      bf16x8 af[8];
      const u16* qrow = PQ + (tok0 + tb * 32 + r) * LD_PQ + h * 256 + pp * 128;
#pragma unroll
      for (int ks = 0; ks < 8; ks++) af[ks] = *(const bf16x8*)(qrow + ks * 16 + hh * 8);
      const u16* kbase = KEYS + ((size_t)(h * 2 + pp) * 128) * 128;
#pragma unroll
      for (int kb = 0; kb < 4; kb++) {
        f32x16 acc;
#pragma unroll
        for (int i = 0; i < 16; i++) acc[i] = 0.f;
#pragma unroll
        for (int ks = 0; ks < 8; ks++) {
          const bf16x8 bfr = *(const bf16x8*)(kbase + (size_t)(kb * 32 + r) * 128 + ks * 16 + hh * 8);
          acc = MFMA32(af[ks], bfr, acc);
        }
#pragma unroll
        for (int i = 0; i < 16; i++) sc[(pp * 64 + tb * 32 + crow(i, hh)) * SST + kb * 32 + r] = acc[i];
      }
    }
    __syncthreads();
    const int tok = tid >> 2, part = tid & 3, pp = part & 1, rng = part >> 1;
    unsigned Lst[16];
    {
      const float* row = sc + (pp * 64 + tok) * SST + rng * 64;
#pragma unroll
      for (int c = 0; c < 4; c++) {
        unsigned S[16];
#pragma unroll
        for (int i = 0; i < 4; i++) {
          const float4 v = *(const float4*)(row + c * 16 + i * 4);
          const unsigned kidx = rng * 64 + c * 16 + i * 4;
          S[4 * i + 0] = (f2ord(v.x) & ~127u) | (kidx + 0);
          S[4 * i + 1] = (f2ord(v.y) & ~127u) | (kidx + 1);
          S[4 * i + 2] = (f2ord(v.z) & ~127u) | (kidx + 2);
          S[4 * i + 3] = (f2ord(v.w) & ~127u) | (kidx + 3);
        }
        sort16_desc(S);
        if (c == 0) {
#pragma unroll
          for (int j = 0; j < 16; j++) Lst[j] = S[j];
        } else merge16_desc(Lst, S);
      }
    }
    {
      unsigned S[16];
#pragma unroll
      for (int j = 0; j < 16; j++) S[j] = (unsigned)__shfl_xor((int)Lst[j], 2);
      merge16_desc(Lst, S);
    }
    unsigned k1[16], k2[16];
#pragma unroll
    for (int j = 0; j < 16; j++) {
      const unsigned o = (unsigned)__shfl_xor((int)Lst[j], 1);
      k1[j] = pp ? o : Lst[j]; k2[j] = pp ? Lst[j] : o;
    }
    if (part < 2) {
#pragma unroll
      for (int j = 0; j < 16; j++) fin[(tok * 2 + part) * 16 + j] = part ? k2[j] : k1[j];
    }
    unsigned L2[16];
    {
      float v1[16], v2[16];
#pragma unroll
      for (int j = 0; j < 16; j++) { v1[j] = ord2f(k1[j] & ~127u); v2[j] = ord2f(k2[j] & ~127u); }
#define CAND(a, b) ((f2ord(v1[a] + v2[b]) & ~255u) | (unsigned)((a) * 16 + (b)))
#pragma unroll
      for (int a = 0; a < 16; a++) L2[a] = CAND(a, 0);
      unsigned S[16];
#pragma unroll
      for (int a = 0; a < 8; a++) { S[a] = CAND(a, 1); S[8 + a] = 0u; }
      merge16_desc(L2, S);
#pragma unroll
      for (int b = 0; b < 8; b++) { S[b] = CAND(0, 8 + b); S[8 + b] = 0u; }
      merge16_desc(L2, S);
      S[0] = CAND(0, 2); S[1] = CAND(1, 2); S[2] = CAND(2, 2); S[3] = CAND(3, 2); S[4] = CAND(4, 2);
      S[5] = CAND(0, 3); S[6] = CAND(1, 3); S[7] = CAND(2, 3); S[8] = CAND(3, 3);
      S[9] = CAND(0, 4); S[10] = CAND(1, 4); S[11] = CAND(2, 4);
      S[12] = CAND(0, 5); S[13] = CAND(1, 5);
      S[14] = CAND(0, 6); S[15] = CAND(1, 6);
      sort16_desc(S);
      merge16_desc(L2, S);
      S[0] = CAND(0, 7); S[1] = CAND(1, 7);
#pragma unroll
      for (int j = 2; j < 16; j++) S[j] = 0u;
      merge16_desc(L2, S);
#undef CAND
    }
    float z = 0.f;
    const float mxv = ord2f(L2[0] & ~255u);
    float ev[16];
#pragma unroll
    for (int j = 0; j < 16; j++) { ev[j] = __expf(ord2f(L2[j] & ~255u) - mxv); z += ev[j]; }
    const float iz = 1.f / z;
    __syncthreads();
    {
      int id[4]; float gv[4], suv[4];
#pragma unroll
      for (int jj = 0; jj < 4; jj++) {
        const unsigned key = (part == 0) ? L2[jj] : (part == 1) ? L2[4 + jj] : (part == 2) ? L2[8 + jj] : L2[12 + jj];
        const float e = (part == 0) ? ev[jj] : (part == 1) ? ev[4 + jj] : (part == 2) ? ev[8 + jj] : ev[12 + jj];
        const int ab = key & 255, a = ab >> 4, b = ab & 15;
        const int i1 = fin[(tok * 2 + 0) * 16 + a] & 127, i2 = fin[(tok * 2 + 1) * 16 + b] & 127;
        id[jj] = i1 * 128 + i2;
        gv[jj] = e * iz * SV[id[jj]];
        suv[jj] = SU[id[jj]];
      }
      const size_t o = (tok0 + tok) * 128 + h * 16 + part * 4;
      *(int4*)(IDX + o) = make_int4(id[0], id[1], id[2], id[3]);
      *(float4*)(GATE + o) = make_float4(gv[0], gv[1], gv[2], gv[3]);
      *(float4*)(SUE + o) = make_float4(suv[0], suv[1], suv[2], suv[3]);
    }
  }
}

DI void ln_row_store16(const float* v, const float* g, const float* bta, int lane, float* outf, u16* outb) {
  float s = 0.f;
#pragma unroll
  for (int i = 0; i < 16; i++) s += v[i];
  const float mu = wave_sum(s) * (1.f / 1024.f);
  float q = 0.f;
#pragma unroll
  for (int i = 0; i < 16; i++) { const float d = v[i] - mu; q += d * d; }
  const float var = wave_sum(q) * (1.f / 1024.f);
  const float rstd = rsqrtf(var + 1e-5f);
  const int c0 = lane * 16;
  float o[16];
#pragma unroll
  for (int k = 0; k < 4; k++) {
    const float4 gg = *(const float4*)(g + c0 + 4 * k), bb = *(const float4*)(bta + c0 + 4 * k);
    o[4 * k + 0] = (v[4 * k + 0] - mu) * rstd * gg.x + bb.x; o[4 * k + 1] = (v[4 * k + 1] - mu) * rstd * gg.y + bb.y;
    o[4 * k + 2] = (v[4 * k + 2] - mu) * rstd * gg.z + bb.z; o[4 * k + 3] = (v[4 * k + 3] - mu) * rstd * gg.w + bb.w;
  }
  if (outf) {
#pragma unroll
    for (int k = 0; k < 4; k++) *(float4*)(outf + c0 + 4 * k) = make_float4(o[4 * k], o[4 * k + 1], o[4 * k + 2], o[4 * k + 3]);
  }
  if (outb) {
    u32x4 a, b;
    a[0] = pack2(o[0], o[1]); a[1] = pack2(o[2], o[3]); a[2] = pack2(o[4], o[5]); a[3] = pack2(o[6], o[7]);
    b[0] = pack2(o[8], o[9]); b[1] = pack2(o[10], o[11]); b[2] = pack2(o[12], o[13]); b[3] = pack2(o[14], o[15]);
    *(u32x4*)(outb + c0) = a; *(u32x4*)(outb + c0 + 8) = b;
  }
}
DI void phase_peer_gather(const Params& p, int L, bool dry = false) {
  char* ws = p.ws;
  const int* IDX = (const int*)(ws + OFF_BIG + BIG_IDX); const float* GATE = (const float*)(ws + OFF_BIG + BIG_GATE);
  const float* SUE = (const float*)(ws + OFF_BIG + BIG_SUE);
  const unsigned char* U8 = (const unsigned char*)(ws + OFF_UB); const unsigned char* V8 = (const unsigned char*)(ws + OFF_VB);
  u16* XB = (u16*)(ws + OFF_XB);
  const float* g = p.ln_g + (size_t)(L * 2 + 1) * 1024; const float* bt = p.ln_b + (size_t)(L * 2 + 1) * 1024;
  const int lane = TIDX() & 63, wave = TIDX() >> 6;
  const int hh = lane >> 5, b4 = (lane >> 4) & 1, b3 = (lane >> 3) & 1;
  const int esel = lane >> 3;
  for (int t = blockIdx.x * 4 + wave; t < T_TOK; t += gridDim.x * 4) {
    f32x2 xv2[8], yv2[8];
    {
      const u32x4* xp = (const u32x4*)(XB + (size_t)t * LDX + lane * 16);
#pragma unroll
      for (int k = 0; k < 2; k++) { const u32x4 a = xp[k];
#pragma unroll
        for (int q = 0; q < 4; q++) { xv2[4 * k + q][0] = bflo(a[q]); xv2[4 * k + q][1] = bfhi(a[q]); } }
    }
#pragma unroll
    for (int i = 0; i < 8; i++) { yv2[i][0] = 0.f; yv2[i][1] = 0.f; }
    const int idx_lo = IDX[(size_t)t * 128 + lane], idx_hi = IDX[(size_t)t * 128 + 64 + lane];
    for (int bch = 0; bch < 16; bch++) {
      const int isrc = (bch < 8) ? idx_lo : idx_hi;
      u32x2 ur[8], vr[8];
#pragma unroll
      for (int jj = 0; jj < 8; jj++) {
        const int e = __builtin_amdgcn_readlane(isrc, ((bch & 7) * 8 + jj));
        ur[jj] = *(const u32x2*)(U8 + (size_t)e * 512 + lane * 8);
        vr[jj] = *(const u32x2*)(V8 + (size_t)e * 512 + lane * 8);
      }
      const float gt = GATE[(size_t)t * 128 + bch * 8 + esel];
      const float sue = SUE[(size_t)t * 128 + bch * 8 + esel];
      float pd[8];
#pragma unroll
      for (int jj = 0; jj < 8; jj++) {
        f32x2 a2 = {0.f, 0.f};
#pragma unroll
        for (int k = 0; k < 2; k++) {
          a2 = __builtin_elementwise_fma(__builtin_amdgcn_cvt_scalef32_pk_f32_fp4(ur[jj][k], 1.0f, 0), xv2[4 * k + 0], a2);
          a2 = __builtin_elementwise_fma(__builtin_amdgcn_cvt_scalef32_pk_f32_fp4(ur[jj][k], 1.0f, 1), xv2[4 * k + 1], a2);
          a2 = __builtin_elementwise_fma(__builtin_amdgcn_cvt_scalef32_pk_f32_fp4(ur[jj][k], 1.0f, 2), xv2[4 * k + 2], a2);
          a2 = __builtin_elementwise_fma(__builtin_amdgcn_cvt_scalef32_pk_f32_fp4(ur[jj][k], 1.0f, 3), xv2[4 * k + 3], a2);
        }
        pd[jj] = a2[0] + a2[1];
      }
      float q4[4], q2[2], q1;
#pragma unroll
      for (int j = 0; j < 4; j++) { const float send = hh ? pd[j] : pd[j + 4]; const float recv = __shfl_xor(send, 32); q4[j] = (hh ? pd[j + 4] : pd[j]) + recv; }
#pragma unroll
      for (int j = 0; j < 2; j++) { const float send = b4 ? q4[j] : q4[j + 2]; const float recv = __shfl_xor(send, 16); q2[j] = (b4 ? q4[j + 2] : q4[j]) + recv; }
      { const float send = b3 ? q2[0] : q2[1]; const float recv = __shfl_xor(send, 8); q1 = (b3 ? q2[1] : q2[0]) + recv; }
      q1 += __shfl_xor(q1, 4); q1 += __shfl_xor(q1, 2); q1 += __shfl_xor(q1, 1);
      const float hv = q1 * sue;
      const float cf = gt * 0.5f * hv * (1.f + erff(hv * 0.70710678118654752f));
#pragma unroll
      for (int jj = 0; jj < 8; jj++) {
        const float c = __int_as_float(__builtin_amdgcn_readlane(__float_as_int(cf), jj * 8));
        const f32x2 c2 = {c, c};
#pragma unroll
        for (int k = 0; k < 2; k++) {
          yv2[4 * k + 0] = __builtin_elementwise_fma(__builtin_amdgcn_cvt_scalef32_pk_f32_fp4(vr[jj][k], 1.0f, 0), c2, yv2[4 * k + 0]);
          yv2[4 * k + 1] = __builtin_elementwise_fma(__builtin_amdgcn_cvt_scalef32_pk_f32_fp4(vr[jj][k], 1.0f, 1), c2, yv2[4 * k + 1]);
          yv2[4 * k + 2] = __builtin_elementwise_fma(__builtin_amdgcn_cvt_scalef32_pk_f32_fp4(vr[jj][k], 1.0f, 2), c2, yv2[4 * k + 2]);
          yv2[4 * k + 3] = __builtin_elementwise_fma(__builtin_amdgcn_cvt_scalef32_pk_f32_fp4(vr[jj][k], 1.0f, 3), c2, yv2[4 * k + 3]);
        }
      }
    }
    float xv[16];
#pragma unroll
    for (int i = 0; i < 8; i++) { xv[2 * i] = DN_ALPHA * xv2[i][0] + yv2[i][0]; xv[2 * i + 1] = DN_ALPHA * xv2[i][1] + yv2[i][1]; }
    if (dry) { if (xv[0] == 1234.5678f) XB[t] = 1; }
    else if (L == 3) ln_row_store16(xv, g, bt, lane, p.out + (size_t)t * 1024, nullptr);
    else ln_row_store16(xv, g, bt, lane, nullptr, XB + (size_t)t * LDX);
  }
}

DI bool phase_applies(int L, int ph) {
  const int kind = L % 3;
  if (ph >= 2 && ph <= 4) return kind == 2;
  if (ph == 6) return kind == 1;
  return true;
}
DI void run_phase(const Params& p, int L, int ph, char* smem) {
  const int kind = L % 3;
  switch (ph) {
    case 0: phase_prep(p, smem); break;
    case 1: phase_inproj(p, L, smem); break;
    case 2: phase_mla_norm(p, smem); break;
    case 3: phase_mla_up(p, smem); break;
    case 4: phase_mla_ropeq(p); break;
    case 5: if (kind == 0) phase_attn_swa(p, L / 3, smem); else if (kind == 1) phase_attn_dil(p, smem); else phase_attn_mla(p, smem); break;
    case 6: phase_dil_mix(p); break;
    case 7: phase_outproj(p, L, smem); break;
    case 8: phase_ln1(p, L); break;
    case 9: phase_peer_q(p, L, smem); break;
    case 10: phase_peer_topk(p, L, smem); break;
    case 11: phase_peer_gather(p, L); break;
  }
}

#if ONE_LAUNCH
#ifndef DUP_LAYERS
#define DUP_LAYERS 15
#endif
#ifndef DUP_MASK
#define DUP_MASK 0
#endif
typedef const __attribute__((address_space(4))) Params* KargPtr;
#if defined(__HIP_DEVICE_COMPILE__)
#define LOAD_PARAMS() KargPtr q_ = kp_; asm volatile("" : "+s"(q_)); Params lp_; __builtin_memcpy(&lp_, (const void*)q_, sizeof(Params))
#else
#define LOAD_PARAMS() const Params lp_ = p
#endif
#define PHASE(L, ph) do { LOAD_PARAMS(); run_phase(lp_, (L), (ph), smem); xcd_barrier2((unsigned*)(lp_.ws + OFF_BAR)); } while (0)
__global__ void __launch_bounds__(NT, 2) mega_kernel(Params p) {
  __shared__ __attribute__((aligned(16))) char smem[SMEM_BYTES];
  cg::grid_group grid = cg::this_grid();
  if (TIDX() == 0) g_xb_words = make_uint4(0u, 0u, 0u, 0u);
  __syncthreads();
#if defined(__HIP_DEVICE_COMPILE__)
  KargPtr kp_ = (KargPtr)__builtin_amdgcn_kernarg_segment_ptr();
#endif
  { LOAD_PARAMS(); (void)xcd_barrier_post((unsigned*)(lp_.ws + OFF_BAR), (volatile LAS unsigned*)&g_xb_words); }
  { LOAD_PARAMS(); run_phase(lp_, 0, 0, smem); }
  grid.sync();
  PHASE(0, 1); PHASE(0, 5); PHASE(0, 7); PHASE(0, 8); PHASE(0, 9); PHASE(0, 10); PHASE(0, 11);
  PHASE(1, 1); PHASE(1, 5); PHASE(1, 6); PHASE(1, 7); PHASE(1, 8); PHASE(1, 9); PHASE(1, 10); PHASE(1, 11);
  PHASE(2, 1); PHASE(2, 2); PHASE(2, 3); PHASE(2, 5); PHASE(2, 7); PHASE(2, 8); PHASE(2, 9); PHASE(2, 10); PHASE(2, 11);
  PHASE(3, 1); PHASE(3, 5); PHASE(3, 7); PHASE(3, 8); PHASE(3, 9); PHASE(3, 10);
  { LOAD_PARAMS(); run_phase(lp_, 3, 11, smem); }
}
#else
__global__ void __launch_bounds__(NT, 2) phase_kernel(Params p, int L, int ph) {
  __shared__ __attribute__((aligned(16))) char smem[SMEM_BYTES];
  run_phase(p, L, ph, smem);
}
#endif

extern "C" void kernel_launch(void* const* d_in, const int* in_sizes, int n_in, void* d_out, int out_size, void* d_ws,
                              size_t ws_size, hipStream_t stream) {
  Params p{};
  p.x = (const float*)d_in[0]; p.rel_bias = (const float*)d_in[1]; p.ln_g = (const float*)d_in[2]; p.ln_b = (const float*)d_in[3];
  p.swa_w_in = (const float*)d_in[4]; p.swa_sinks = (const float*)d_in[5]; p.swa_w_out = (const float*)d_in[6];
  p.dil_w_in = (const float*)d_in[7]; p.dil_w_out = (const float*)d_in[8];
  p.mla_w_in = (const float*)d_in[9]; p.mla_q_norm = (const float*)d_in[10]; p.mla_w_uq = (const float*)d_in[11];
  p.mla_kv_norm = (const float*)d_in[12]; p.mla_w_ukv = (const float*)d_in[13]; p.mla_w_out = (const float*)d_in[14];
  p.peer_w_q = (const float*)d_in[15]; p.peer_keys = (const float*)d_in[16]; p.peer_u = (const float*)d_in[17]; p.peer_v = (const float*)d_in[18];
  p.out = (float*)d_out; p.ws = (char*)d_ws;
  if (ws_size < WS_TOTAL) { fprintf(stderr, "workspace too small: %zu < %zu\n", ws_size, (size_t)WS_NEEDED); return; }
#if ONE_LAUNCH
  static int grid_blocks = 0;
  if (!grid_blocks) {
    int dev = 0, cus = 0, per_cu = 0;
    hipGetDevice(&dev);
    hipDeviceGetAttribute(&cus, hipDeviceAttributeMultiprocessorCount, dev);
    hipOccupancyMaxActiveBlocksPerMultiprocessor(&per_cu, mega_kernel, NT, 0);
    if (per_cu > 2) per_cu = 2;
    if (per_cu < 1) per_cu = 1;
    grid_blocks = cus * per_cu;
  }
  (void)hipMemsetAsync((char*)d_ws + OFF_BAR, 0, XCD_BAR_WORDS * 4, stream);
  void* args[] = {&p};
  hipError_t e = hipLaunchCooperativeKernel((void*)mega_kernel, dim3(grid_blocks), dim3(NT), args, 0, stream);
  if (e != hipSuccess) fprintf(stderr, "cooperative launch failed: %s (grid %d)\n", hipGetErrorString(e), grid_blocks);
#else
  const int grid_blocks = 512;
  phase_kernel<<<grid_blocks, NT, 0, stream>>>(p, 0, 0);
  for (int L = 0; L < 4; L++)
    for (int ph = 1; ph <= 11; ph++) {
      const int kind = L % 3;
      bool ok = true;
      if (ph >= 2 && ph <= 4) ok = (kind == 2);
      if (ph == 6) ok = (kind == 1);
      if (ok) phase_kernel<<<grid_blocks, NT, 0, stream>>>(p, L, ph);
    }
#endif
}
```
